# Optimizing an MI355X kernel written in HIP

```python
import math
import jax, jax.numpy as jnp
from jax import lax
import numpy as np

D_MODEL = 2048
BATCH = 8
SEQ = 2048
DEPTH = 1
DEC_BATCH = 4
DEC_SEQ = 2048
PAST_LEN = 128

GRID_W = 64
HEAD_DIM = 128
NA_HEADS = 8
DN_HEADS = 8
NA_WIDTH = NA_HEADS * HEAD_DIM
DN_WIDTH = DN_HEADS * HEAD_DIM
MIX_WIDTH = NA_WIDTH + DN_WIDTH
NA_ROWS_MAX = 8
NA_COLS = 16
CONV_K = 5
CHUNK = 64
D_FF = -(-8 * D_MODEL // (3 * 256)) * 256
RMS_EPS = 1e-6
L2_EPS = 1e-6

OFF_NA = 0
OFF_DN = OFF_NA + 3 * NA_WIDTH
OFF_Z = OFF_DN + 3 * DN_WIDTH
OFF_B = OFF_Z + DN_WIDTH
OFF_A = OFF_B + 2 * DN_HEADS
IN_COLS = OFF_A + 2 * DN_HEADS

kernel_name = "hybrid_na_gdn_encoder"


def rmsnorm(x, w):
    x32 = x.astype(jnp.float32)
    y = x32 * lax.rsqrt(jnp.mean(x32 * x32, axis=-1, keepdims=True) + RMS_EPS)
    return (y * w.astype(jnp.float32)).astype(x.dtype)


def l2norm(x):
    return x * lax.rsqrt(jnp.sum(x * x, axis=-1, keepdims=True) + L2_EPS)


def neighbourhood_attention(q, k, v, rpb):
    B, L, H, d = q.shape
    rows = L // GRID_W
    kr = min(NA_ROWS_MAX, rows)
    grid = lambda t: t.reshape(B, rows, GRID_W, H, d)
    qg, kg, vg = grid(q * (d ** -0.5)), grid(k), grid(v)
    cols = jnp.arange(GRID_W)
    col_start = jnp.clip(cols - NA_COLS // 2, 0, GRID_W - NA_COLS)
    col_idx = col_start[:, None] + jnp.arange(NA_COLS)[None, :]
    dc_idx = col_idx - cols[:, None] + (NA_COLS - 1)

    def row_block(r):
        rs = jnp.clip(r - kr // 2, 0, rows - kr)
        q_r = lax.dynamic_index_in_dim(qg, r, axis=1, keepdims=False)
        k_band = lax.dynamic_slice_in_dim(kg, rs, kr, axis=1)
        v_band = lax.dynamic_slice_in_dim(vg, rs, kr, axis=1)
        k_win = k_band[:, :, col_idx]
        v_win = v_band[:, :, col_idx]
        dr_idx = rs + jnp.arange(kr) - r + (NA_ROWS_MAX - 1)
        bias = rpb[:, dr_idx[None, :, None], dc_idx[:, None, :]]
        s = jnp.einsum('bchd,brcwhd->bhcrw', q_r, k_win).astype(jnp.float32) + bias.astype(jnp.float32)
        p = jax.nn.softmax(s.reshape(B, H, GRID_W, kr * NA_COLS), axis=-1)
        p = p.reshape(s.shape).astype(v.dtype)
        return jnp.einsum('bhcrw,brcwhd->bchd', p, v_win)

    out = lax.map(row_block, jnp.arange(rows))
    return out.transpose(1, 0, 2, 3, 4).reshape(B, L, H * d)


def centred_depthwise_conv(x, w):
    C = x.shape[-1]
    return lax.conv_general_dilated(
        x, w[:, None, :].astype(x.dtype), window_strides=(1,),
        padding=[(CONV_K // 2, CONV_K // 2)],
        dimension_numbers=('NWC', 'WIO', 'NWC'), feature_group_count=C)


def chunk_gated_delta_rule(q, k, v, g, beta):
    B, L, H, dk = q.shape
    n = L // CHUNK
    chunks = lambda t: t.reshape(B, n, CHUNK, H, -1).transpose(0, 3, 1, 2, 4)
    q = chunks(q * (dk ** -0.5))
    k, v = chunks(k), chunks(v)
    g = jnp.cumsum(g.reshape(B, n, CHUNK, H).transpose(0, 3, 1, 2), axis=-1)
    beta = beta.reshape(B, n, CHUNK, H).transpose(0, 3, 1, 2)
    tri = jnp.tril(jnp.ones((CHUNK, CHUNK), dtype=bool))
    strict = jnp.tril(jnp.ones((CHUNK, CHUNK), dtype=bool), k=-1)
    diff = g[..., :, None] - g[..., None, :]
    decay = jnp.where(tri, jnp.exp(jnp.where(tri, diff, 0.0)), 0.0)
    k_beta = k * beta[..., None]
    v_beta = v * beta[..., None]
    a_mat = jnp.where(strict, jnp.einsum('bhncd,bhnsd->bhncs', k_beta, k) * decay, 0.0)
    eye = jnp.eye(CHUNK, dtype=jnp.float32)
    t_mat = lax.linalg.triangular_solve(eye + a_mat, jnp.broadcast_to(eye, a_mat.shape),
                                        left_side=True, lower=True, unit_diagonal=True)
    u = jnp.einsum('bhncs,bhnse->bhnce', t_mat, v_beta)
    w = jnp.einsum('bhncs,bhnsd->bhncd', t_mat, k_beta * jnp.exp(g)[..., None])
    qk = jnp.where(tri, jnp.einsum('bhncd,bhnsd->bhncs', q, k) * decay, 0.0)

    def step(S, inp):
        q_i, k_i, u_i, w_i, g_i, qk_i = inp
        v_new = u_i - jnp.einsum('bhcd,bhde->bhce', w_i, S)
        o = jnp.einsum('bhcd,bhde->bhce', q_i * jnp.exp(g_i)[..., None], S) \
            + jnp.einsum('bhcs,bhse->bhce', qk_i, v_new)
        g_last = g_i[..., -1]
        S = S * jnp.exp(g_last)[..., None, None] + jnp.einsum(
            'bhcd,bhce->bhde', k_i * jnp.exp(g_last[..., None] - g_i)[..., None], v_new)
        return S, o

    to_scan = lambda t: jnp.moveaxis(t, 2, 0)
    xs = (to_scan(q), to_scan(k), to_scan(u), to_scan(w), to_scan(g), to_scan(qk))
    S0 = jnp.zeros((B, H, dk, v.shape[-1]), jnp.float32)
    _, o = lax.scan(step, S0, xs)
    return o.transpose(1, 0, 3, 2, 4).reshape(B, L, H, -1)


def gated_deltanet_bidir(qkv, z, b, a, conv_w, A_log, dt_bias, norm_w):
    B, L, _ = qkv.shape
    qkv = jax.nn.silu(centred_depthwise_conv(qkv, conv_w).astype(jnp.float32))
    q, k, v = jnp.split(qkv, 3, axis=-1)
    heads = lambda t: t.reshape(B, L, DN_HEADS, HEAD_DIM)
    q, k, v = l2norm(heads(q)), l2norm(heads(k)), heads(v)
    beta = jax.nn.sigmoid(b.astype(jnp.float32)).reshape(B, L, 2, DN_HEADS)
    g = -jnp.exp(A_log.astype(jnp.float32)) * jax.nn.softplus(
        a.astype(jnp.float32).reshape(B, L, 2, DN_HEADS) + dt_bias.astype(jnp.float32))
    flip = lambda t: jnp.flip(t, axis=1)
    o_fwd = chunk_gated_delta_rule(q, k, v, g[:, :, 0], beta[:, :, 0])
    o_bwd = flip(chunk_gated_delta_rule(flip(q), flip(k), flip(v), flip(g[:, :, 1]), flip(beta[:, :, 1])))
    o = o_fwd + o_bwd
    o = o * lax.rsqrt(jnp.mean(o * o, axis=-1, keepdims=True) + RMS_EPS) * norm_w.astype(jnp.float32)
    o = o * jax.nn.silu(heads(z).astype(jnp.float32))
    return o.reshape(B, L, DN_WIDTH)


def encoder_layer(h, norm_mix_w, w_in, na_rpb, dn_conv_w, dn_A_log, dn_dt_bias, dn_norm_w,
                  w_out, norm_ffn_w, w_gate, w_up, w_down):
    B, L, _ = h.shape
    xn = rmsnorm(h, norm_mix_w)
    proj = xn @ w_in
    na = lambda i: proj[..., OFF_NA + i * NA_WIDTH: OFF_NA + (i + 1) * NA_WIDTH].reshape(
        B, L, NA_HEADS, HEAD_DIM)
    y_na = neighbourhood_attention(na(0), na(1), na(2), na_rpb)
    y_dn = gated_deltanet_bidir(proj[..., OFF_DN:OFF_Z], proj[..., OFF_Z:OFF_B],
                                proj[..., OFF_B:OFF_A], proj[..., OFF_A:IN_COLS],
                                dn_conv_w, dn_A_log, dn_dt_bias, dn_norm_w)
    mixed = jnp.concatenate([y_na, y_dn.astype(h.dtype)], axis=-1) @ w_out
    h = h + mixed
    hn = rmsnorm(h, norm_ffn_w)
    return h + (jax.nn.silu(hn @ w_gate) * (hn @ w_up)) @ w_down


def trunk(x, norm_mix_w, w_in, na_rpb, dn_conv_w, dn_A_log, dn_dt_bias, dn_norm_w,
          w_out, norm_ffn_w, w_gate, w_up, w_down, final_norm_w):
    h = x
    for i in range(DEPTH):
        h = encoder_layer(h, norm_mix_w[i], w_in[i], na_rpb[i], dn_conv_w[i], dn_A_log[i],
                          dn_dt_bias[i], dn_norm_w[i], w_out[i], norm_ffn_w[i],
                          w_gate[i], w_up[i], w_down[i])
    return rmsnorm(h, final_norm_w)


def setup_inputs(seed: int = 0) -> dict:
    key = jax.random.key(seed)
    ks = jax.random.split(key, 16)
    f32 = jnp.float32
    nrm = lambda k, shape, fan_in: jax.random.normal(k, shape, f32) * (fan_in ** -0.5)
    gain = lambda k, shape: 1.0 + 0.02 * jax.random.normal(k, shape, f32)
    dt = jnp.exp(jax.random.uniform(ks[7], (DEPTH, 2, DN_HEADS), f32,
                                    math.log(1e-3), math.log(1e-1)))
    return {
        "x_prompt": jax.random.normal(ks[0], (BATCH, SEQ, D_MODEL), f32),
        "x_sample": jax.random.normal(ks[1], (DEC_BATCH, DEC_SEQ, D_MODEL), f32),
        "norm_mix_w": gain(ks[2], (DEPTH, D_MODEL)),
        "w_in": nrm(ks[3], (DEPTH, D_MODEL, IN_COLS), D_MODEL),
        "na_rpb": 0.02 * jax.random.normal(ks[4], (DEPTH, NA_HEADS, 2 * NA_ROWS_MAX - 1, 2 * NA_COLS - 1), f32),
        "dn_conv_w": nrm(ks[5], (DEPTH, CONV_K, 3 * DN_WIDTH), CONV_K),
        "dn_A_log": jnp.log(jax.random.uniform(ks[6], (DEPTH, 2, DN_HEADS), f32, 1.0, 16.0)),
        "dn_dt_bias": dt + jnp.log(-jnp.expm1(-dt)),
        "dn_norm_w": gain(ks[8], (DEPTH, HEAD_DIM)),
        "w_out": nrm(ks[9], (DEPTH, MIX_WIDTH, D_MODEL), MIX_WIDTH),
        "norm_ffn_w": gain(ks[10], (DEPTH, D_MODEL)),
        "w_gate": nrm(ks[11], (DEPTH, D_MODEL, D_FF), D_MODEL),
        "w_up": nrm(ks[12], (DEPTH, D_MODEL, D_FF), D_MODEL),
        "w_down": nrm(ks[13], (DEPTH, D_FF, D_MODEL), D_FF),
        "final_norm_w": gain(ks[14], (D_MODEL,)),
    }


def reference(x_prompt, x_sample, norm_mix_w, w_in, na_rpb, dn_conv_w, dn_A_log, dn_dt_bias,
              dn_norm_w, w_out, norm_ffn_w, w_gate, w_up, w_down, final_norm_w):
    y_prompt = trunk(x_prompt, norm_mix_w, w_in, na_rpb, dn_conv_w, dn_A_log, dn_dt_bias,
                     dn_norm_w, w_out, norm_ffn_w, w_gate, w_up, w_down, final_norm_w)
    y_sample = trunk(x_sample, norm_mix_w, w_in, na_rpb, dn_conv_w, dn_A_log, dn_dt_bias,
                     dn_norm_w, w_out, norm_ffn_w, w_gate, w_up, w_down, final_norm_w)
    return (y_prompt, y_sample)
```

```cpp
#include <hip/hip_runtime.h>
#include <cstdio>
#include <cstdint>
namespace pg8 {
#define PG8_LAS __attribute__((address_space(3)))
typedef unsigned short bf16_t;
typedef short bf16x8 __attribute__((ext_vector_type(8)));
typedef float f32x4 __attribute__((ext_vector_type(4)));
typedef unsigned u32x4 __attribute__((ext_vector_type(4)));
constexpr int BM = 256, BK = 64, HALF = 128, HTB = HALF * BK * 2  , STAGE_BYTES = 8 * HTB, NXCD = 8, WGM = 8;

__host__ __device__ __forceinline__ int lds_byte(int r, int c) { const int st = (r >> 4) * 2 + (c >> 5), rr = r & 15, cc = c & 31, ob = rr * 64 + cc * 2; return st * 1024 + (ob ^ (((ob >> 9) & 1) << 5)); }
__host__ __device__ __forceinline__ void stage_rc(int b, int& R, int& C) { const int st = b / 1024, sb = b % 1024, swz = sb ^ (((sb >> 9) & 1) << 5); R = (st >> 1) * 16 + swz / 64; C = (st & 1) * 32 + (swz % 64) / 2; }
__host__ __device__ __forceinline__ int perm32(int rho) { const int n = rho >> 4, i = rho & 15; return 8 * (i >> 2) + 4 * n + (i & 3); }

struct Unit { int pm, pn; };
struct Gemm { const bf16_t* A; const bf16_t* Bt; int M, N, K; };

struct StaticOrder {
    int nM, nN, nwg, G, c;
    __host__ __device__ void init(int M, int N, int G_, int c_) { nM = M / BM; nN = N / BM; nwg = nM * nN; G = G_; c = c_; }
    __host__ __device__ bool next(int i, Unit& u) const {
        const long L = (long)i * G + c; if (L >= nwg) return false;
        int wgid = (int)L; { const int q = nwg / NXCD, r = nwg % NXCD, xcd = wgid % NXCD, off = wgid / NXCD; wgid = (xcd < r ? xcd * (q + 1) : r * (q + 1) + (xcd - r) * q) + off; }
        const int nig = WGM * nN, gid = wgid / nig, fm = gid * WGM, gsz = (nM - fm) < WGM ? (nM - fm) : WGM;
        u.pm = fm + ((wgid % nig) % gsz); u.pn = (wgid % nig) / gsz; return true;
    }
    __device__ __forceinline__ void a_ready(const Unit&) const {}
    __device__ __forceinline__ void done(const Unit&) const {}
};

__device__ __forceinline__ unsigned cvt_pk_bf16(float lo, float hi) { unsigned r; asm volatile("v_cvt_pk_bf16_f32 %0, %1, %2" : "=v"(r) : "v"(lo), "v"(hi)); return r; }
typedef float f32x2 __attribute__((ext_vector_type(2)));
template <class Epi, class Sched, bool ALIGN_EPI = false, bool SP2 = false>
__device__ __forceinline__ void gemm_phase(PG8_LAS unsigned char* lds, const Gemm g, const Sched& S, const Epi& E) {
    const int tid = threadIdx.x, wid = __builtin_amdgcn_readfirstlane(tid >> 6), lane = tid & 63, wr = wid >> 2, wc = wid & 3, fr = lane & 15, fq = lane >> 4;
    const int K = g.K, nt = K / BK;
    unsigned voffA[2], voffB[2];
#pragma unroll
    for (int i = 0; i < 2; ++i) { int R, C; stage_rc(tid * 16 + i * 8192, R, C); const int Rb = Epi::PERM ? ((R & ~31) + perm32(R & 31)) : R;
        voffA[i] = (unsigned)(R * K + C) * 2u; voffB[i] = (unsigned)(Rb * K + C) * 2u; }
    const size_t kstep = (size_t)(BK * 2);
    const size_t hstep = (size_t)HALF * K * 2;
    const size_t tstep = 2 * hstep;
    const unsigned ldsw = (unsigned)wid * 1024u;
    const int aoff = lds_byte(wr * 64 + fr, fq * 8), boff = lds_byte(wc * 32 + fr, fq * 8);
#define PG8_SA(b, h) (((b) * 2 + (h)) * HTB)
#define PG8_SB(b, h) ((4 + (b) * 2 + (h)) * HTB)
#define PG8_STAGE(bufoff, gbase, voff) do { _Pragma("unroll") for (int _i = 0; _i < 2; ++_i) \
        __builtin_amdgcn_global_load_lds((const unsigned*)((const char*)(gbase) + (voff)[_i]), (PG8_LAS unsigned*)(lds + (bufoff) + ldsw + _i * 8192), 16, 0, 0); } while (0)
#define PG8_LDA(dst, b, h) do { _Pragma("unroll") for (int m = 0; m < 4; ++m) _Pragma("unroll") for (int k = 0; k < 2; ++k) dst[m][k] = *(const PG8_LAS bf16x8*)(lds + PG8_SA(b, h) + aoff + m * 2048 + k * 1024); } while (0)
#define PG8_LDB(dst, b, h) do { _Pragma("unroll") for (int n = 0; n < 2; ++n) _Pragma("unroll") for (int k = 0; k < 2; ++k) dst[n][k] = *(const PG8_LAS bf16x8*)(lds + PG8_SB(b, h) + boff + n * 2048 + k * 1024); } while (0)
#define PG8_MMA(ai, bj, At, Bt) do { __builtin_amdgcn_s_setprio(1); _Pragma("unroll") for (int m = 0; m < 4; ++m) _Pragma("unroll") for (int n = 0; n < 2; ++n) _Pragma("unroll") for (int k = 0; k < 2; ++k) \
        acc[ai][bj][m][n] = __builtin_amdgcn_mfma_f32_16x16x32_bf16(Bt[n][k], At[m][k], acc[ai][bj][m][n], 0, 0, 0); __builtin_amdgcn_s_setprio(0); } while (0)
#define PG8_WAIT_V(n) asm volatile("s_waitcnt vmcnt(" #n ")" ::: "memory")
#define PG8_WAIT_L(n) asm volatile("s_waitcnt lgkmcnt(" #n ")" ::: "memory")
#define PG8_BAR __builtin_amdgcn_s_barrier()
#define PG8_SCHED __builtin_amdgcn_sched_barrier(0)
    Unit cur, nxt; int ui = 0;
    if (!S.next(0, cur)) return;
    f32x4 acc[2][2][4][2];
#pragma unroll
    for (int a = 0; a < 2; ++a)
#pragma unroll
        for (int b = 0; b < 2; ++b)
#pragma unroll
            for (int m = 0; m < 4; ++m)
#pragma unroll
                for (int n = 0; n < 2; ++n) acc[a][b][m][n] = (f32x4){0.f, 0.f, 0.f, 0.f};
    bf16x8 At[4][2], B0[2][2], B1[2][2];
    const char* cA = (const char*)g.A + (size_t)cur.pm * tstep; const char* cB = (const char*)g.Bt + (size_t)cur.pn * tstep;
    S.a_ready(cur);
    if constexpr (SP2) {
        PG8_STAGE(PG8_SB(0, 0), cB, voffB); PG8_STAGE(PG8_SB(0, 1), cB + hstep, voffB); PG8_STAGE(PG8_SA(0, 0), cA, voffA); PG8_STAGE(PG8_SA(0, 1), cA + hstep, voffA);
        if (wr == 1) PG8_BAR;
        PG8_WAIT_V(2); PG8_BAR;
        PG8_STAGE(PG8_SB(1, 0), cB + kstep, voffB); PG8_STAGE(PG8_SA(1, 0), cA + kstep, voffA); PG8_STAGE(PG8_SB(1, 1), cB + hstep + kstep, voffB);
        PG8_WAIT_V(6); PG8_BAR;
    } else {
        PG8_STAGE(PG8_SB(0, 0), cB, voffB); PG8_STAGE(PG8_SA(0, 0), cA, voffA); PG8_STAGE(PG8_SB(0, 1), cB + hstep, voffB); PG8_STAGE(PG8_SA(0, 1), cA + hstep, voffA);
        if (wr == 1) PG8_BAR;
        PG8_WAIT_V(4); PG8_BAR;
        PG8_STAGE(PG8_SB(1, 0), cB + kstep, voffB); PG8_STAGE(PG8_SA(1, 0), cA + kstep, voffA); PG8_STAGE(PG8_SB(1, 1), cB + hstep + kstep, voffB);
        PG8_WAIT_V(6); PG8_BAR;
    }
    for (;;) {
        const bool has_next = S.next(ui + 1, nxt);
        const char* nA = has_next ? (const char*)g.A + (size_t)nxt.pm * tstep : cA; const char* nB = has_next ? (const char*)g.Bt + (size_t)nxt.pn * tstep : cB;
        for (int t = 0; t < nt; t += 2) {
            const bool last = (t == nt - 2);
            const char* a1 = cA + (size_t)(t + 1) * kstep;
            const char* a2 = last ? nA : cA + (size_t)(t + 2) * kstep; const char* b2 = last ? nB : cB + (size_t)(t + 2) * kstep;
            const char* a3 = a2 + kstep; const char* b3 = b2 + kstep;
            if (last && has_next) S.a_ready(nxt);
            if constexpr (SP2) {
            PG8_LDB(B0, 0, 0); PG8_LDB(B1, 0, 1); PG8_SCHED; PG8_LDA(At, 0, 0); PG8_STAGE(PG8_SA(1, 1), a1 + hstep, voffA);
            PG8_WAIT_V(8); PG8_WAIT_L(0); PG8_BAR; PG8_MMA(0, 0, At, B0); PG8_MMA(0, 1, At, B1); PG8_BAR; PG8_SCHED;
            PG8_LDA(At, 0, 1); PG8_STAGE(PG8_SB(0, 0), b2, voffB); PG8_STAGE(PG8_SB(0, 1), b2 + hstep, voffB); PG8_STAGE(PG8_SA(0, 0), a2, voffA);
            PG8_WAIT_V(8); PG8_WAIT_L(0); PG8_BAR; PG8_MMA(1, 0, At, B0); PG8_MMA(1, 1, At, B1); PG8_BAR; PG8_SCHED;
            PG8_LDB(B0, 1, 0); PG8_LDB(B1, 1, 1); PG8_SCHED; PG8_LDA(At, 1, 0); PG8_STAGE(PG8_SA(0, 1), a2 + hstep, voffA);
            PG8_WAIT_V(8); PG8_WAIT_L(0); PG8_BAR; PG8_MMA(0, 0, At, B0); PG8_MMA(0, 1, At, B1); PG8_BAR; PG8_SCHED;
            PG8_LDA(At, 1, 1); PG8_STAGE(PG8_SB(1, 0), b3, voffB); PG8_STAGE(PG8_SB(1, 1), b3 + hstep, voffB); PG8_STAGE(PG8_SA(1, 0), a3, voffA);
            PG8_WAIT_V(8); PG8_WAIT_L(0); PG8_BAR; PG8_MMA(1, 0, At, B0); PG8_MMA(1, 1, At, B1); PG8_BAR; PG8_SCHED;
            } else {
            PG8_LDB(B0, 0, 0); PG8_SCHED; PG8_LDA(At, 0, 0); PG8_STAGE(PG8_SA(1, 1), a1 + hstep, voffA);
            PG8_WAIT_L(8); PG8_BAR; PG8_WAIT_L(0); PG8_MMA(0, 0, At, B0); PG8_BAR; PG8_SCHED;
            PG8_LDB(B1, 0, 1); PG8_STAGE(PG8_SB(0, 0), b2, voffB);
            PG8_BAR; PG8_WAIT_L(0); PG8_MMA(0, 1, At, B1); PG8_BAR;
            PG8_LDA(At, 0, 1); PG8_STAGE(PG8_SA(0, 0), a2, voffA);
            PG8_BAR; PG8_WAIT_L(0); PG8_MMA(1, 0, At, B0); PG8_BAR; PG8_SCHED;
            PG8_STAGE(PG8_SB(0, 1), b2 + hstep, voffB);
            PG8_WAIT_V(6); PG8_BAR; PG8_MMA(1, 1, At, B1); PG8_BAR;
            PG8_LDB(B0, 1, 0); PG8_SCHED; PG8_LDA(At, 1, 0); PG8_STAGE(PG8_SA(0, 1), a2 + hstep, voffA);
            PG8_WAIT_L(8); PG8_BAR; PG8_WAIT_L(0); PG8_MMA(0, 0, At, B0); PG8_BAR; PG8_SCHED;
            PG8_LDB(B1, 1, 1); PG8_STAGE(PG8_SB(1, 0), b3, voffB);
            PG8_BAR; PG8_WAIT_L(0); PG8_MMA(0, 1, At, B1); PG8_BAR;
            PG8_LDA(At, 1, 1); PG8_STAGE(PG8_SA(1, 0), a3, voffA);
            PG8_BAR; PG8_WAIT_L(0); PG8_MMA(1, 0, At, B0); PG8_BAR; PG8_SCHED;
            PG8_STAGE(PG8_SB(1, 1), b3 + hstep, voffB);
            PG8_WAIT_V(6); PG8_BAR; PG8_MMA(1, 1, At, B1); PG8_BAR;
            }
        }
        if constexpr (ALIGN_EPI) { if (wr == 0) PG8_BAR; }
        if constexpr (!Epi::AFTER_DRAIN) { E(acc, cur, wr, wc, fr, fq); S.done(cur); }
        if (!has_next) break;
#pragma unroll
        for (int a = 0; a < 2; ++a)
#pragma unroll
            for (int b = 0; b < 2; ++b)
#pragma unroll
                for (int m = 0; m < 4; ++m)
#pragma unroll
                    for (int n = 0; n < 2; ++n) acc[a][b][m][n] = (f32x4){0.f, 0.f, 0.f, 0.f};
        cur = nxt; cA = nA; cB = nB; ++ui;
        if constexpr (ALIGN_EPI) { if (wr == 1) PG8_BAR; }
    }
    PG8_WAIT_V(0);
    if constexpr (!ALIGN_EPI) { if (wr == 0) PG8_BAR; }
    PG8_BAR;
    if constexpr (Epi::AFTER_DRAIN) { E.fused(acc, cur, wr, wc, fr, fq, lds, wid, lane); S.done(cur); }
#undef PG8_SA
#undef PG8_SB
#undef PG8_STAGE
#undef PG8_LDA
#undef PG8_LDB
#undef PG8_MMA
#undef PG8_WAIT_V
#undef PG8_WAIT_L
#undef PG8_BAR
#undef PG8_SCHED
}
}

#ifndef MK_N_LAUNCHES
#define MK_N_LAUNCHES 0
#endif
#ifndef NA_MODE
#define NA_MODE 0
#endif
#ifndef DN_MODE
#define DN_MODE 0
#endif
constexpr int NPHASE = 11;

constexpr int DM = 2048, SEQ = 2048, NSEQ = 12, M = NSEQ * SEQ, MP = 8 * SEQ;
constexpr int NIN = 7200, NPROJ = 7424;
constexpr int DFF = 5632, NGU = 2 * DFF;
constexpr int HD = 128, NH = 8;
constexpr float RMS_EPS = 1e-6f, L2_EPS = 1e-6f, QSCALE = 0.08838834764831845f;

constexpr size_t MiB = 1u << 20;
constexpr size_t WS_CTL = 0, CTL_ZERO_BYTES = 1 * MiB;
constexpr size_t WS_BA = 1 * MiB;
constexpr size_t WS_WO = 4 * MiB, WS_W1 = 12 * MiB, WS_W3 = 41 * MiB, WS_W4 = 85 * MiB;
constexpr size_t WS_XN = 112 * MiB;
constexpr size_t WS_PROJ = 208 * MiB, PROJ_STRIDE = 48 * MiB;
constexpr size_t WS_O = 352 * MiB;
constexpr size_t WS_PRE = 576 * MiB;
constexpr size_t WS_Z = 720 * MiB;
constexpr size_t WS_ACT = 208 * MiB;
constexpr size_t WS_END = 768 * MiB;
constexpr int CW_TMO = 0, CW_CODE = 1, CW_BAR = 4096;

constexpr int RING_OFF = 0, RING_BYTES = 131072;
constexpr int LDSCTL_OFF = RING_BYTES, MISC_OFF = LDSCTL_OFF + 320;
constexpr int LDS_BYTES = 147456;

#define GAS __attribute__((address_space(1)))
#define LAS __attribute__((address_space(3)))
typedef unsigned short bf16;
typedef unsigned v4u __attribute__((ext_vector_type(4)));
typedef unsigned v2u __attribute__((ext_vector_type(2)));
typedef float f32x4 __attribute__((ext_vector_type(4)));
typedef float f32x2 __attribute__((ext_vector_type(2)));
typedef GAS unsigned gu32;
#define RLX_AGENT __ATOMIC_RELAXED, __HIP_MEMORY_SCOPE_AGENT
#define LDS_WAIT() asm volatile("s_waitcnt lgkmcnt(0)" ::: "memory")
#define VM_WAIT() asm volatile("s_waitcnt vmcnt(0)" ::: "memory")

__device__ __forceinline__ float bf_lo(unsigned v) { return __uint_as_float(v << 16); }
__device__ __forceinline__ float bf_hi(unsigned v) { return __uint_as_float(v & 0xffff0000u); }
__device__ __forceinline__ float bf2f(bf16 b) { return __uint_as_float(((unsigned)b) << 16); }
__device__ __forceinline__ unsigned pk2(float lo, float hi) { return pg8::cvt_pk_bf16(lo, hi); }
__device__ __forceinline__ float wave_sum(float v) {
#pragma unroll
    for (int o = 1; o < 64; o <<= 1) v += __shfl_xor(v, o);
    return v;
}
__device__ __forceinline__ float wave_max(float v) {
#pragma unroll
    for (int o = 1; o < 64; o <<= 1) v = fmaxf(v, __shfl_xor(v, o));
    return v;
}
__device__ __forceinline__ float silu_f(float x) { return x * __builtin_amdgcn_rcpf(1.0f + __expf(-x)); }
__device__ __forceinline__ float sigmoid_f(float x) { return 1.0f / (1.0f + expf(-x)); }
__device__ __forceinline__ float softplus_f(float x) { return fmaxf(x, 0.f) + log1pf(expf(-fabsf(x))); }

namespace pg8 {
struct EpiProj {
    static constexpr bool PERM = true, AFTER_DRAIN = false;
    bf16_t* P; size_t stride; bf16_t* Z; float* BA;
    __device__ __forceinline__ void operator()(const f32x4 (&acc)[2][2][4][2], const Unit& u, int wr, int wc, int fr, int fq) const {
        const int row0 = u.pm * BM + wr * 64 + fr;
        if (u.pn < 28) {
            const int t = u.pn >> 2; bf16_t* base = (t < 6) ? P + (size_t)t * stride : Z;
            const int col0 = (u.pn & 3) * BM + wc * 32 + 8 * fq;
#pragma unroll
            for (int ai = 0; ai < 2; ++ai)
#pragma unroll
                for (int m = 0; m < 4; ++m) { bf16_t* rowp = base + (size_t)(row0 + ai * HALF + m * 16) * 1024 + col0;
#pragma unroll
                    for (int bj = 0; bj < 2; ++bj) { const f32x4 v0 = acc[ai][bj][m][0], v1 = acc[ai][bj][m][1];
                        u32x4 w; w.x = cvt_pk_bf16(v0[0], v0[1]); w.y = cvt_pk_bf16(v0[2], v0[3]); w.z = cvt_pk_bf16(v1[0], v1[1]); w.w = cvt_pk_bf16(v1[2], v1[3]);
                        *(u32x4*)(rowp + bj * HALF) = w; } }
        } else if (wc == 0) {
#pragma unroll
            for (int ai = 0; ai < 2; ++ai)
#pragma unroll
                for (int m = 0; m < 4; ++m) { float* rowp = BA + (size_t)(row0 + ai * HALF + m * 16) * 32 + 8 * fq;
                    *(f32x4*)(rowp) = acc[ai][0][m][0]; *(f32x4*)(rowp + 4) = acc[ai][0][m][1]; }
        }
    }
};
struct EpiResid {
    static constexpr bool PERM = false, AFTER_DRAIN = false;
    const float* xp; const float* xs; float* out;
    __device__ __forceinline__ void operator()(const f32x4 (&acc)[2][2][4][2], const Unit& u, int wr, int wc, int fr, int fq) const {
        const int row0 = u.pm * BM + wr * 64 + fr, col0 = u.pn * BM + wc * 32 + 4 * fq;
        const float* xb = (u.pm * BM < MP) ? xp : xs - (size_t)MP * DM;
#pragma unroll
        for (int ai = 0; ai < 2; ++ai)
#pragma unroll
            for (int m = 0; m < 4; ++m) { const size_t off = (size_t)(row0 + ai * HALF + m * 16) * DM + col0;
#pragma unroll
                for (int bj = 0; bj < 2; ++bj)
#pragma unroll
                    for (int n = 0; n < 2; ++n) { const f32x4 xv = *(const f32x4*)(xb + off + bj * HALF + n * 16); *(f32x4*)(out + off + bj * HALF + n * 16) = xv + acc[ai][bj][m][n]; } }
    }
};
struct EpiAccum {
    static constexpr bool PERM = false, AFTER_DRAIN = false;
    float* out;
    __device__ __forceinline__ void operator()(const f32x4 (&acc)[2][2][4][2], const Unit& u, int wr, int wc, int fr, int fq) const {
        const int row0 = u.pm * BM + wr * 64 + fr, col0 = u.pn * BM + wc * 32 + 4 * fq;
#pragma unroll
        for (int ai = 0; ai < 2; ++ai)
#pragma unroll
            for (int m = 0; m < 4; ++m) { const size_t off = (size_t)(row0 + ai * HALF + m * 16) * DM + col0;
#pragma unroll
                for (int bj = 0; bj < 2; ++bj)
#pragma unroll
                    for (int n = 0; n < 2; ++n) { float* p = out + off + bj * HALF + n * 16; const f32x4 hv = *(const f32x4*)p; *(f32x4*)p = hv + acc[ai][bj][m][n]; } }
    }
};
struct EpiSwiGLU {
    static constexpr bool PERM = true, AFTER_DRAIN = false;
    bf16_t* O;
    __device__ __forceinline__ void operator()(const f32x4 (&acc)[2][2][4][2], const Unit& u, int wr, int wc, int fr, int fq) const {
        const int row0 = u.pm * BM + wr * 64 + fr, col0 = u.pn * HALF + wc * 32 + 8 * fq;
#pragma unroll
        for (int ai = 0; ai < 2; ++ai)
#pragma unroll
            for (int m = 0; m < 4; ++m) { bf16_t* rowp = O + (size_t)(row0 + ai * HALF + m * 16) * DFF + col0;
                float r[8];
#pragma unroll
                for (int n = 0; n < 2; ++n)
#pragma unroll
                    for (int j = 0; j < 4; ++j) { const float g = acc[ai][0][m][n][j], up = acc[ai][1][m][n][j]; r[4 * n + j] = g * __builtin_amdgcn_rcpf(1.0f + __expf(-g)) * up; }
                u32x4 w; w.x = cvt_pk_bf16(r[0], r[1]); w.y = cvt_pk_bf16(r[2], r[3]); w.z = cvt_pk_bf16(r[4], r[5]); w.w = cvt_pk_bf16(r[6], r[7]);
                *(u32x4*)rowp = w; }
    }
};
}

#ifndef PG8_SP2
#define PG8_SP2 true
#endif
#ifndef PG8_ALIGN
#define PG8_ALIGN true
#endif

#define XB_TMO      128
#define XB_XCNT(j)  (256  + 64 * (j))
#define XB_XSUB(j)  (1280 + 64 * (j))
#define XB_XGEN(j)  (2304 + 64 * (j))
#define XB_TOP      3328
#define XB_TOPGEN   3392
#define XCD_BAR_WORDS 3456
#define XB_SPIN_CAP (1u << 18)

__device__ __forceinline__ unsigned xb_ld(unsigned* p)              { return __hip_atomic_load(p, __ATOMIC_RELAXED, __HIP_MEMORY_SCOPE_AGENT); }
__device__ __forceinline__ unsigned xb_add(unsigned* p, unsigned v) { return __hip_atomic_fetch_add(p, v, __ATOMIC_RELAXED, __HIP_MEMORY_SCOPE_AGENT); }
__device__ __forceinline__ unsigned xb_xcc_id() { return (unsigned)__builtin_amdgcn_s_getreg((3 << 11) | 20) & 0xFu; }
#define XB_SPIN(cond, bar) do { unsigned _sp = 0; while (cond) { __builtin_amdgcn_s_sleep(1); \
    if ((++_sp & 255u) == 0u) { if (xb_ld(&(bar)[XB_TMO])) break; if (_sp > XB_SPIN_CAP) { atomicAdd(&(bar)[XB_TMO], 1u); break; } } } } while (0)

struct XcdBarrier {
    unsigned* bar; unsigned x;
    volatile LAS unsigned* st;
};

__device__ __forceinline__ XcdBarrier xcd_barrier_post(unsigned* bar, volatile LAS unsigned* st) {
    XcdBarrier b; b.bar = bar; b.x = xb_xcc_id(); b.st = st;
    if (threadIdx.x == 0) (void)xb_add(&bar[XB_XCNT(b.x)], 1u);
    return b;
}
__device__ __forceinline__ void xcd_barrier_complete(unsigned* bar, unsigned x, unsigned& nloc, unsigned& nx) {
    const unsigned G = gridDim.x * gridDim.y * gridDim.z;
    unsigned sum, cnt, mine, sp = 0u;
    for (;;) {
        sum = 0u; cnt = 0u; mine = 0u;
#pragma unroll
        for (unsigned j = 0; j < 16; ++j) { const unsigned c = xb_ld(&bar[XB_XCNT(j)]); sum += c; cnt += (c > 0u) ? 1u : 0u; mine = (j == x) ? c : mine; }
        if (sum == G) break;
        __builtin_amdgcn_s_sleep(1);
        if ((++sp & 255u) == 0u) { if (xb_ld(&bar[XB_TMO])) break; if (sp > XB_SPIN_CAP) { atomicAdd(&bar[XB_TMO], 1u); break; } }
    }
    nloc = mine > 0u ? mine : 1u; nx = cnt > 0u ? cnt : 1u;
}

__device__ __forceinline__ void xcd_barrier(const XcdBarrier& b) {
    asm volatile("s_waitcnt vmcnt(0)" ::: "memory");
    __syncthreads();
    if (threadIdx.x == 0) {
        unsigned* bar = b.bar;
        __builtin_amdgcn_s_waitcnt(0);
        unsigned nloc = b.st[0], nx = b.st[1];
        if (nloc == 0u) { xcd_barrier_complete(bar, b.x, nloc, nx); b.st[0] = nloc; b.st[1] = nx; }
        const unsigned old = xb_add(&bar[XB_XSUB(b.x)], 1u);
        const unsigned gen = old / nloc;
        if (old + 1u == (gen + 1u) * nloc) {
            __builtin_amdgcn_fence(__ATOMIC_RELEASE, "agent");
            asm volatile("s_waitcnt vmcnt(0)" ::: "memory");
            const unsigned og = xb_add(&bar[XB_TOP], 1u);
            const unsigned tg = og / nx;
            if (og + 1u == (tg + 1u) * nx) xb_add(&bar[XB_TOPGEN], 1u);
            else XB_SPIN(xb_ld(&bar[XB_TOPGEN]) == tg, bar);
            __builtin_amdgcn_fence(__ATOMIC_ACQUIRE, "agent");
            xb_add(&bar[XB_XGEN(b.x)], 1u);
            asm volatile("s_waitcnt vmcnt(0)" ::: "memory");
        } else {
            XB_SPIN(xb_ld(&bar[XB_XGEN(b.x)]) == gen, bar);
            __builtin_amdgcn_fence(__ATOMIC_ACQUIRE, "agent");
            asm volatile("s_waitcnt vmcnt(0)" ::: "memory");
        }
    }
    __syncthreads();
}


__device__ __forceinline__ void p0_transpose_item(const float* W, int ldw, int k0, int n0, bf16* WT, int ldt, int dst_row0, LAS float* scr, int lane) {
#pragma unroll 8
    for (int i = 0; i < 32; ++i) { const int kk = 2 * i + (lane >> 5); scr[kk * 33 + (lane & 31)] = W[(size_t)(k0 + kk) * ldw + n0 + (lane & 31)]; }
    LDS_WAIT(); asm volatile("" ::: "memory");
    const int c = lane & 7;
#pragma unroll
    for (int j = 0; j < 4; ++j) { const int n = (lane >> 3) + 8 * j; const LAS float* s = scr + (8 * c) * 33 + n;
        v4u o; o.x = pk2(s[0 * 33], s[1 * 33]); o.y = pk2(s[2 * 33], s[3 * 33]); o.z = pk2(s[4 * 33], s[5 * 33]); o.w = pk2(s[6 * 33], s[7 * 33]);
        *(GAS v4u*)(WT + (size_t)(dst_row0 + n) * ldt + k0 + 8 * c) = o; }
    LDS_WAIT(); asm volatile("" ::: "memory");
}
__device__ __forceinline__ void rms_row_to_bf16(const float* xrow, const float* w, bf16* orow, int lane) {
    const f32x4* xr = (const f32x4*)xrow + lane; const f32x4* wr = (const f32x4*)w + lane;
    f32x4 v[8]; float s = 0.f;
#pragma unroll
    for (int j = 0; j < 8; ++j) { v[j] = xr[64 * j]; s += (v[j].x * v[j].x + v[j].y * v[j].y) + (v[j].z * v[j].z + v[j].w * v[j].w); }
    const float rstd = rsqrtf(wave_sum(s) * (1.f / DM) + RMS_EPS);
    v2u* o8 = (v2u*)orow + lane;
#pragma unroll
    for (int j = 0; j < 8; ++j) { const f32x4 g = wr[64 * j]; v2u o; o.x = pk2(v[j].x * rstd * g.x, v[j].y * rstd * g.y); o.y = pk2(v[j].z * rstd * g.z, v[j].w * rstd * g.w); o8[64 * j] = o; }
}
__device__ __forceinline__ void rms_row_inplace(float* xrow, const float* w, int lane) {
    f32x4* xr = (f32x4*)xrow + lane; const f32x4* wr = (const f32x4*)w + lane;
    f32x4 v[8]; float s = 0.f;
#pragma unroll
    for (int j = 0; j < 8; ++j) { v[j] = xr[64 * j]; s += (v[j].x * v[j].x + v[j].y * v[j].y) + (v[j].z * v[j].z + v[j].w * v[j].w); }
    const float rstd = rsqrtf(wave_sum(s) * (1.f / DM) + RMS_EPS);
#pragma unroll
    for (int j = 0; j < 8; ++j) { const f32x4 g = wr[64 * j]; xr[64 * j] = v[j] * rstd * g; }
}

struct Ptrs {
    const float *xp, *xs, *norm_mix_w, *w_in, *rpb, *conv_w, *A_log, *dt_bias, *dn_norm_w, *w_out, *norm_ffn_w, *w_gate, *w_up, *w_down, *final_norm_w;
    float* out; unsigned char* ws;
};

__device__ __forceinline__ void p0_prologue(const Ptrs& P, LAS unsigned char* lds, int gw, int NGW, int wave, int lane) {
    LAS float* scr = (LAS float*)(lds + RING_OFF + wave * 16384);
    bf16* W1t = (bf16*)(P.ws + WS_W1); bf16* WOt = (bf16*)(P.ws + WS_WO); bf16* W3t = (bf16*)(P.ws + WS_W3); bf16* W4t = (bf16*)(P.ws + WS_W4);
    constexpr int I_1 = (DM / 64) * (NIN / 32), I_O = (DM / 64) * (DM / 32), I_G = (DM / 64) * (DFF / 32), I_D = (DFF / 64) * (DM / 32);
    constexpr int NITEMS = I_1 + I_O + 2 * I_G + I_D;
    for (int it = gw; it < NITEMS; it += NGW) {
        int r = it;
        if (r < I_1) { const int nb = r % (NIN / 32), kb = r / (NIN / 32); p0_transpose_item(P.w_in, NIN, 64 * kb, 32 * nb, W1t, DM, 32 * nb, scr, lane); continue; } r -= I_1;
        if (r < I_O) { const int nb = r % (DM / 32), kb = r / (DM / 32); p0_transpose_item(P.w_out, DM, 64 * kb, 32 * nb, WOt, DM, 32 * nb, scr, lane); continue; } r -= I_O;
        if (r < 2 * I_G) { const int up = r >= I_G; if (up) r -= I_G; const int nb = r % (DFF / 32), kb = r / (DFF / 32); const int n0 = 32 * nb;
            p0_transpose_item(up ? P.w_up : P.w_gate, DFF, 64 * kb, n0, W3t, DM, 256 * (n0 >> 7) + (n0 & 127) + (up ? 128 : 0), scr, lane); continue; } r -= 2 * I_G;
        { const int nb = r % (DM / 32), kb = r / (DM / 32); p0_transpose_item(P.w_down, DM, 64 * kb, 32 * nb, W4t, DFF, 32 * nb, scr, lane); }
    }
    { const v4u z = {0u, 0u, 0u, 0u}; v4u* zp = (v4u*)(W1t + (size_t)NIN * DM);
      for (int i = gw * 64 + lane; i < (NPROJ - NIN) * DM / 8; i += NGW * 64) zp[i] = z; }
    bf16* XN = (bf16*)(P.ws + WS_XN);
    for (int m = gw; m < M; m += NGW) { const float* xr = (m < MP) ? P.xp + (size_t)m * DM : P.xs + (size_t)(m - MP) * DM; rms_row_to_bf16(xr, P.norm_mix_w, XN + (size_t)m * DM, lane); }
}

__device__ __forceinline__ float dot8(const v4u a, const v4u b) {
    return (bf_lo(a.x) * bf_lo(b.x) + bf_hi(a.x) * bf_hi(b.x)) + (bf_lo(a.y) * bf_lo(b.y) + bf_hi(a.y) * bf_hi(b.y)) + (bf_lo(a.z) * bf_lo(b.z) + bf_hi(a.z) * bf_hi(b.z)) + (bf_lo(a.w) * bf_lo(b.w) + bf_hi(a.w) * bf_hi(b.w));
}
__device__ __forceinline__ void na_naive(const Ptrs& P, int gw, int NGW, int lane) {
    const bf16* Q = (const bf16*)(P.ws + WS_PROJ); const bf16* K = (const bf16*)(P.ws + WS_PROJ + PROJ_STRIDE); const bf16* V = (const bf16*)(P.ws + WS_PROJ + 2 * PROJ_STRIDE);
    bf16* Y = (bf16*)(P.ws + WS_XN);
    for (int it = gw; it < M * NH; it += NGW) {
        const int m = it >> 3, h = it & 7, b = m >> 11, t = m & 2047, r = t >> 6, c = t & 63;
        const int rs = min(max(r - 4, 0), 24), cs = min(max(c - 8, 0), 48);
        const v4u* qp = (const v4u*)(Q + (size_t)m * 1024 + h * HD);
        float sc[2];
#pragma unroll
        for (int s = 0; s < 2; ++s) { const int kk = lane + 64 * s, i = kk >> 4, j = kk & 15; const size_t km = (size_t)b * SEQ + (rs + i) * 64 + cs + j;
            const v4u* kp = (const v4u*)(K + km * 1024 + h * HD); float a = 0.f;
#pragma unroll
            for (int x = 0; x < 16; ++x) a += dot8(qp[x], kp[x]);
            sc[s] = a * QSCALE + P.rpb[(h * 15 + (rs + i - r + 7)) * 31 + (cs + j - c + 15)]; }
        const float mx = wave_max(fmaxf(sc[0], sc[1]));
        float p0 = expf(sc[0] - mx), p1 = expf(sc[1] - mx);
        const float inv = 1.0f / wave_sum(p0 + p1); p0 *= inv; p1 *= inv;
        float o0 = 0.f, o1 = 0.f;
        for (int kk = 0; kk < 128; ++kk) { const float p = __shfl(kk < 64 ? p0 : p1, kk & 63); const int i = kk >> 4, j = kk & 15; const size_t km = (size_t)b * SEQ + (rs + i) * 64 + cs + j;
            const unsigned vv = *(const unsigned*)(V + km * 1024 + h * HD + 2 * lane); o0 += p * bf_lo(vv); o1 += p * bf_hi(vv); }
        *(unsigned*)(Y + (size_t)m * DM + h * HD + 2 * lane) = pk2(o0, o1);
    }
}
__device__ __forceinline__ void dn_conv_naive(const Ptrs& P, int gw, int NGW, int lane) {
    const bf16* X = (const bf16*)(P.ws + WS_PROJ + 3 * PROJ_STRIDE); bf16* DNC = (bf16*)(P.ws + WS_PRE);
    for (int it = gw; it < M * NH * 3; it += NGW) {
        const int w = it % 3, mh = it / 3, h = mh & 7, m = mh >> 3, t = m & 2047;
        const int ch = h * HD + 2 * lane; const bf16* xb = X + (size_t)w * (PROJ_STRIDE / 2) + ch;
        float y0 = 0.f, y1 = 0.f;
#pragma unroll
        for (int j = 0; j < 5; ++j) { const int tt = t + j - 2; if (tt >= 0 && tt < SEQ) { const unsigned xv = *(const unsigned*)(xb + (size_t)(m + j - 2) * 1024);
                const f32x2 cw = *(const f32x2*)(P.conv_w + (size_t)j * 3072 + w * 1024 + ch); y0 += cw.x * bf_lo(xv); y1 += cw.y * bf_hi(xv); } }
        y0 = y0 / (1.0f + expf(-y0)); y1 = y1 / (1.0f + expf(-y1));
        if (w < 2) { const float ss = wave_sum(y0 * y0 + y1 * y1); const float rn = rsqrtf(ss + L2_EPS); y0 *= rn; y1 *= rn; }
        *(unsigned*)(DNC + (size_t)m * 3072 + w * 1024 + ch) = pk2(y0, y1);
    }
}
__device__ __forceinline__ void dn_scan_naive(const Ptrs& P, LAS unsigned char* lds, int tid) {
    const bf16* DNC = (const bf16*)(P.ws + WS_PRE); const float* BA = (const float*)(P.ws + WS_BA); float* O = (float*)(P.ws + WS_O);
    const int grp = tid >> 8, e = (tid & 255) >> 1, half = tid & 1, x = tid & 255;
    LAS float* kq = (LAS float*)(lds + grp * 1024);
    for (int cb = blockIdx.x; cb < NSEQ * NH * 2 / 2; cb += gridDim.x) {
        const int chain = cb * 2 + grp, b = chain >> 4, h = (chain >> 1) & 7, dir = chain & 1;
        const float Aexp = expf(P.A_log[dir * 8 + h]), dtb = P.dt_bias[dir * 8 + h];
        float* Od = O + (size_t)dir * M * 1024;
        float s[64];
#pragma unroll
        for (int d = 0; d < 64; ++d) s[d] = 0.f;
        for (int step = 0; step < SEQ; ++step) {
            const int t = dir ? SEQ - 1 - step : step; const size_t m = (size_t)b * SEQ + t;
            kq[x] = bf2f(DNC[m * 3072 + (x < 128 ? 1024 + h * HD + x : h * HD + x - 128)]);
            const float v = bf2f(DNC[m * 3072 + 2048 + h * HD + e]);
            const float beta = sigmoid_f(BA[m * 32 + dir * 8 + h]);
            const float eg = expf(-Aexp * softplus_f(BA[m * 32 + 16 + dir * 8 + h] + dtb));
            __syncthreads();
            float dot = 0.f;
#pragma unroll
            for (int d = 0; d < 64; ++d) { s[d] *= eg; dot += kq[half * 64 + d] * s[d]; }
            dot += __shfl_xor(dot, 1);
            const float err = (v - dot) * beta; float o = 0.f;
#pragma unroll
            for (int d = 0; d < 64; ++d) { s[d] += err * kq[half * 64 + d]; o += kq[128 + half * 64 + d] * s[d]; }
            o += __shfl_xor(o, 1);
            if (half == 0) Od[m * 1024 + h * HD + e] = o * QSCALE;
            __syncthreads();
        }
    }
}
__device__ __forceinline__ void dn_combine(const Ptrs& P, int gw, int NGW, int lane) {
    const float* O = (const float*)(P.ws + WS_O); const bf16* Z = (const bf16*)(P.ws + WS_Z); bf16* Y = (bf16*)(P.ws + WS_XN);
    const f32x2 nw = *(const f32x2*)(P.dn_norm_w + 2 * lane);
    for (int it = gw; it < M * NH; it += NGW) {
        const int m = it >> 3, h = it & 7; const size_t off = (size_t)m * 1024 + h * HD + 2 * lane;
        const f32x2 a = *(const f32x2*)(O + off), bq = *(const f32x2*)(O + (size_t)M * 1024 + off);
        const float o0 = a.x + bq.x, o1 = a.y + bq.y;
        const float rn = rsqrtf(wave_sum(o0 * o0 + o1 * o1) * (1.0f / HD) + RMS_EPS);
        const unsigned zz = *(const unsigned*)(Z + off); const float z0 = bf_lo(zz), z1 = bf_hi(zz);
        const float y0 = o0 * rn * nw.x * (z0 / (1.0f + expf(-z0))), y1 = o1 * rn * nw.y * (z1 / (1.0f + expf(-z1)));
        *(unsigned*)(Y + (size_t)m * DM + 1024 + h * HD + 2 * lane) = pk2(y0, y1);
    }
}

struct Args { const float* in[15]; float* out; unsigned char* ws; int ph_lo, ph_hi, li, pad; };
__global__ void __launch_bounds__(512, 2) fwd(Args args) {
    extern __shared__ __attribute__((aligned(16))) unsigned char lds_raw[];
    LAS unsigned char* lds = (LAS unsigned char*)lds_raw;
    const int tid = threadIdx.x, lane = tid & 63, wave = __builtin_amdgcn_readfirstlane(tid >> 6);
    const int G = gridDim.x, gw = blockIdx.x * 8 + wave, NGW = G * 8;
    Ptrs P;
    P.xp = args.in[0]; P.xs = args.in[1]; P.norm_mix_w = args.in[2]; P.w_in = args.in[3]; P.rpb = args.in[4]; P.conv_w = args.in[5]; P.A_log = args.in[6]; P.dt_bias = args.in[7];
    P.dn_norm_w = args.in[8]; P.w_out = args.in[9]; P.norm_ffn_w = args.in[10]; P.w_gate = args.in[11]; P.w_up = args.in[12]; P.w_down = args.in[13]; P.final_norm_w = args.in[14];
    P.out = args.out; P.ws = args.ws;
    gu32* ctl = (gu32*)(P.ws + WS_CTL);
    volatile LAS unsigned* MISC = (volatile LAS unsigned*)(lds + MISC_OFF);
    for (int u = tid; u < (LDS_BYTES - LDSCTL_OFF) / 4; u += 512) ((LAS unsigned*)(lds + LDSCTL_OFF))[u] = 0u;
    __syncthreads();
    const int lo = args.ph_lo, hi = args.ph_hi;
    XcdBarrier bar; bar.bar = (unsigned*)(ctl + CW_BAR); bar.x = 0; bar.st = nullptr;
    if (hi - lo > 1) bar = xcd_barrier_post((unsigned*)(ctl + CW_BAR), MISC + 8);
#define IN(k) (lo <= (k) && (k) < hi)
#define SEAM(k) do { if (IN(k) && IN((k) + 1)) xcd_barrier(bar); } while (0)

    bf16* XN = (bf16*)(P.ws + WS_XN);
    if (IN(0)) { p0_prologue(P, lds, gw, NGW, wave, lane); } SEAM(0);
    if (IN(1)) {
        pg8::Gemm g{XN, (const bf16*)(P.ws + WS_W1), M, NPROJ, DM}; pg8::StaticOrder S; S.init(M, NPROJ, G, (int)blockIdx.x);
        pg8::EpiProj E{(bf16*)(P.ws + WS_PROJ), PROJ_STRIDE / 2, (bf16*)(P.ws + WS_Z), (float*)(P.ws + WS_BA)};
        pg8::gemm_phase<pg8::EpiProj, pg8::StaticOrder, PG8_ALIGN, PG8_SP2>(lds + RING_OFF, g, S, E);
    } SEAM(1);
    if (IN(2)) { na_naive(P, gw, NGW, lane); } SEAM(2);
    if (IN(3)) { dn_conv_naive(P, gw, NGW, lane); } SEAM(3);
    if (IN(4)) { dn_scan_naive(P, lds, tid); } SEAM(4);
    if (IN(5)) { dn_combine(P, gw, NGW, lane); } SEAM(5);
    if (IN(6)) {
        pg8::Gemm g{XN, (const bf16*)(P.ws + WS_WO), M, DM, DM}; pg8::StaticOrder S; S.init(M, DM, G, (int)blockIdx.x);
        pg8::EpiResid E{P.xp, P.xs, P.out};
        pg8::gemm_phase<pg8::EpiResid, pg8::StaticOrder, PG8_ALIGN, PG8_SP2>(lds + RING_OFF, g, S, E);
    } SEAM(6);
    if (IN(7)) { for (int m = gw; m < M; m += NGW) rms_row_to_bf16(P.out + (size_t)m * DM, P.norm_ffn_w, XN + (size_t)m * DM, lane); } SEAM(7);
    if (IN(8)) {
        pg8::Gemm g{XN, (const bf16*)(P.ws + WS_W3), M, NGU, DM}; pg8::StaticOrder S; S.init(M, NGU, G, (int)blockIdx.x);
        pg8::EpiSwiGLU E{(bf16*)(P.ws + WS_ACT)};
        pg8::gemm_phase<pg8::EpiSwiGLU, pg8::StaticOrder, PG8_ALIGN, PG8_SP2>(lds + RING_OFF, g, S, E);
    } SEAM(8);
    if (IN(9)) {
        pg8::Gemm g{(const bf16*)(P.ws + WS_ACT), (const bf16*)(P.ws + WS_W4), M, DM, DFF}; pg8::StaticOrder S; S.init(M, DM, G, (int)blockIdx.x);
        pg8::EpiAccum E{P.out};
        pg8::gemm_phase<pg8::EpiAccum, pg8::StaticOrder, PG8_ALIGN, PG8_SP2>(lds + RING_OFF, g, S, E);
    } SEAM(9);
    if (IN(10)) { for (int m = gw; m < M; m += NGW) rms_row_inplace(P.out + (size_t)m * DM, P.final_norm_w, lane); }
#undef IN
#undef SEAM
}

extern "C" void kernel_launch(void* const* d_in, const int* in_sizes, int n_in, void* d_out, int out_size, void* d_ws, size_t ws_size, hipStream_t stream) {
    static int grid = 0;
    if (grid == 0) {
        if (n_in != 15 || out_size != M * DM || ws_size < WS_END) { fprintf(stderr, "kernel_launch: unexpected shapes (n_in %d out %d ws %zu)\n", n_in, out_size, ws_size); grid = -1; return; }
        int dev = 0, cus = 0, per_cu = 0;
        if (hipGetDevice(&dev) != hipSuccess || hipDeviceGetAttribute(&cus, hipDeviceAttributeMultiprocessorCount, dev) != hipSuccess) { grid = -1; return; }
        if (hipFuncSetAttribute((const void*)fwd, hipFuncAttributeMaxDynamicSharedMemorySize, LDS_BYTES) != hipSuccess) { grid = -1; return; }
        if (hipOccupancyMaxActiveBlocksPerMultiprocessor(&per_cu, (const void*)fwd, 512, LDS_BYTES) != hipSuccess || per_cu < 1) fprintf(stderr, "kernel_launch: occupancy query says %d\n", per_cu);
        (void)hipGetLastError();
        grid = cus;
    }
    if (grid < 0) return;
    if (hipMemsetAsync((char*)d_ws + WS_CTL, 0, CTL_ZERO_BYTES, stream) != hipSuccess) return;
    Args a{};
    for (int i = 0; i < 15; ++i) a.in[i] = (const float*)d_in[i];
    a.out = (float*)d_out; a.ws = (unsigned char*)d_ws;
    if (MK_N_LAUNCHES == 1) {
        a.ph_lo = 0; a.ph_hi = NPHASE; a.li = 0;
        hipLaunchKernelGGL(fwd, dim3(grid), dim3(512), LDS_BYTES, stream, a);
    } else {
        for (int p = 0; p < NPHASE; ++p) { a.ph_lo = p; a.ph_hi = p + 1; a.li = p; hipLaunchKernelGGL(fwd, dim3(grid), dim3(512), LDS_BYTES, stream, a); }
    }
}
```

```cpp
#include <hip/hip_runtime.h>
#include <cstdio>
#include <cstdint>

namespace pg8 {
#define PG8_LAS __attribute__((address_space(3)))
typedef unsigned short bf16_t;
typedef short bf16x8 __attribute__((ext_vector_type(8)));
typedef float f32x4 __attribute__((ext_vector_type(4)));
typedef unsigned u32x4 __attribute__((ext_vector_type(4)));
constexpr int BM = 256, BK = 64, HALF = 128, HTB = HALF * BK * 2  , STAGE_BYTES = 8 * HTB, NXCD = 8, WGM = 8;

__host__ __device__ __forceinline__ int lds_byte(int r, int c) { const int st = (r >> 4) * 2 + (c >> 5), rr = r & 15, cc = c & 31, ob = rr * 64 + cc * 2; return st * 1024 + (ob ^ (((ob >> 9) & 1) << 5)); }
__host__ __device__ __forceinline__ void stage_rc(int b, int& R, int& C) { const int st = b / 1024, sb = b % 1024, swz = sb ^ (((sb >> 9) & 1) << 5); R = (st >> 1) * 16 + swz / 64; C = (st & 1) * 32 + (swz % 64) / 2; }
__host__ __device__ __forceinline__ int perm32(int rho) { const int n = rho >> 4, i = rho & 15; return 8 * (i >> 2) + 4 * n + (i & 3); }

struct Unit { int pm, pn; };
struct Gemm { const bf16_t* A; const bf16_t* Bt; int M, N, K; };

struct StaticOrder {
    int nM, nN, nwg, G, c;
    __host__ __device__ void init(int M, int N, int G_, int c_) { nM = M / BM; nN = N / BM; nwg = nM * nN; G = G_; c = c_; }
    __host__ __device__ bool next(int i, Unit& u) const {
        const long L = (long)i * G + c; if (L >= nwg) return false;
        int wgid = (int)L; { const int q = nwg / NXCD, r = nwg % NXCD, xcd = wgid % NXCD, off = wgid / NXCD; wgid = (xcd < r ? xcd * (q + 1) : r * (q + 1) + (xcd - r) * q) + off; }
        const int nig = WGM * nN, gid = wgid / nig, fm = gid * WGM, gsz = (nM - fm) < WGM ? (nM - fm) : WGM;
        u.pm = fm + ((wgid % nig) % gsz); u.pn = (wgid % nig) / gsz; return true;
    }
    __device__ __forceinline__ void a_ready(const Unit&) const {}
    __device__ __forceinline__ void done(const Unit&) const {}
};

__device__ __forceinline__ unsigned cvt_pk_bf16(float lo, float hi) { unsigned r; asm volatile("v_cvt_pk_bf16_f32 %0, %1, %2" : "=v"(r) : "v"(lo), "v"(hi)); return r; }
typedef float f32x2 __attribute__((ext_vector_type(2)));
template <class Epi, class Sched, bool ALIGN_EPI = false, bool SP2 = false>
__device__ __forceinline__ void gemm_phase(PG8_LAS unsigned char* lds, const Gemm g, const Sched& S, const Epi& E, const int wid, const int lane) {
    const int tid = wid * 64 + lane, wr = wid >> 2, wc = wid & 3, fr = lane & 15, fq = lane >> 4;
    const int K = g.K, nt = K / BK;
    unsigned voffA[2], voffB[2];
#pragma unroll
    for (int i = 0; i < 2; ++i) { int R, C; stage_rc(tid * 16 + i * 8192, R, C); const int Rb = Epi::PERM ? ((R & ~31) + perm32(R & 31)) : R;
        voffA[i] = (unsigned)(R * K + C) * 2u; voffB[i] = (unsigned)(Rb * K + C) * 2u; }
    const size_t kstep = (size_t)(BK * 2);
    const size_t hstep = (size_t)HALF * K * 2;
    const size_t tstep = 2 * hstep;
    const unsigned ldsw = (unsigned)wid * 1024u;
    const int aoff = lds_byte(wr * 64 + fr, fq * 8), boff = lds_byte(wc * 32 + fr, fq * 8);
#define PG8_SA(b, h) (((b) * 2 + (h)) * HTB)
#define PG8_SB(b, h) ((4 + (b) * 2 + (h)) * HTB)
#define PG8_STAGE(bufoff, gbase, voff) do { _Pragma("unroll") for (int _i = 0; _i < 2; ++_i) \
        __builtin_amdgcn_global_load_lds((const unsigned*)((const char*)(gbase) + (voff)[_i]), (PG8_LAS unsigned*)(lds + (bufoff) + ldsw + _i * 8192), 16, 0, 0); } while (0)
#define PG8_LDA(dst, b, h) do { _Pragma("unroll") for (int m = 0; m < 4; ++m) _Pragma("unroll") for (int k = 0; k < 2; ++k) dst[m][k] = *(const PG8_LAS bf16x8*)(lds + PG8_SA(b, h) + aoff + m * 2048 + k * 1024); } while (0)
#define PG8_LDB(dst, b, h) do { _Pragma("unroll") for (int n = 0; n < 2; ++n) _Pragma("unroll") for (int k = 0; k < 2; ++k) dst[n][k] = *(const PG8_LAS bf16x8*)(lds + PG8_SB(b, h) + boff + n * 2048 + k * 1024); } while (0)
#define PG8_MMA(ai, bj, At, Bt) do { __builtin_amdgcn_s_setprio(1); _Pragma("unroll") for (int m = 0; m < 4; ++m) _Pragma("unroll") for (int n = 0; n < 2; ++n) _Pragma("unroll") for (int k = 0; k < 2; ++k) \
        acc[ai][bj][m][n] = __builtin_amdgcn_mfma_f32_16x16x32_bf16(Bt[n][k], At[m][k], acc[ai][bj][m][n], 0, 0, 0); __builtin_amdgcn_s_setprio(0); } while (0)
#define PG8_WAIT_V(n) asm volatile("s_waitcnt vmcnt(" #n ")" ::: "memory")
#define PG8_WAIT_L(n) asm volatile("s_waitcnt lgkmcnt(" #n ")" ::: "memory")
#define PG8_BAR __builtin_amdgcn_s_barrier()
#define PG8_SCHED __builtin_amdgcn_sched_barrier(0)
    Unit cur, nxt; int ui = 0;
    if (!S.next(0, cur)) return;
    f32x4 acc[2][2][4][2];
#pragma unroll
    for (int a = 0; a < 2; ++a)
#pragma unroll
        for (int b = 0; b < 2; ++b)
#pragma unroll
            for (int m = 0; m < 4; ++m)
#pragma unroll
                for (int n = 0; n < 2; ++n) acc[a][b][m][n] = (f32x4){0.f, 0.f, 0.f, 0.f};
    bf16x8 At[4][2], B0[2][2], B1[2][2];
    const char* cA = (const char*)g.A + (size_t)cur.pm * tstep; const char* cB = (const char*)g.Bt + (size_t)cur.pn * tstep;
    S.a_ready(cur);
    if constexpr (SP2) {
        PG8_STAGE(PG8_SB(0, 0), cB, voffB); PG8_STAGE(PG8_SB(0, 1), cB + hstep, voffB); PG8_STAGE(PG8_SA(0, 0), cA, voffA); PG8_STAGE(PG8_SA(0, 1), cA + hstep, voffA);
        if (wr == 1) PG8_BAR;
        PG8_WAIT_V(2); PG8_BAR;
        PG8_STAGE(PG8_SB(1, 0), cB + kstep, voffB); PG8_STAGE(PG8_SA(1, 0), cA + kstep, voffA); PG8_STAGE(PG8_SB(1, 1), cB + hstep + kstep, voffB);
        PG8_WAIT_V(6); PG8_BAR;
    } else {
        PG8_STAGE(PG8_SB(0, 0), cB, voffB); PG8_STAGE(PG8_SA(0, 0), cA, voffA); PG8_STAGE(PG8_SB(0, 1), cB + hstep, voffB); PG8_STAGE(PG8_SA(0, 1), cA + hstep, voffA);
        if (wr == 1) PG8_BAR;
        PG8_WAIT_V(4); PG8_BAR;
        PG8_STAGE(PG8_SB(1, 0), cB + kstep, voffB); PG8_STAGE(PG8_SA(1, 0), cA + kstep, voffA); PG8_STAGE(PG8_SB(1, 1), cB + hstep + kstep, voffB);
        PG8_WAIT_V(6); PG8_BAR;
    }
    for (;;) {
        const bool has_next = S.next(ui + 1, nxt);
        const char* nA = has_next ? (const char*)g.A + (size_t)nxt.pm * tstep : cA; const char* nB = has_next ? (const char*)g.Bt + (size_t)nxt.pn * tstep : cB;
        for (int t = 0; t < nt; t += 2) {
            const bool last = (t == nt - 2);
            const char* a1 = cA + (size_t)(t + 1) * kstep;
            const char* a2 = last ? nA : cA + (size_t)(t + 2) * kstep; const char* b2 = last ? nB : cB + (size_t)(t + 2) * kstep;
            const char* a3 = a2 + kstep; const char* b3 = b2 + kstep;
            if (last && has_next) S.a_ready(nxt);
            if constexpr (SP2) {
            PG8_LDB(B0, 0, 0); PG8_LDB(B1, 0, 1); PG8_SCHED; PG8_LDA(At, 0, 0); PG8_STAGE(PG8_SA(1, 1), a1 + hstep, voffA);
            PG8_WAIT_V(8); PG8_WAIT_L(0); PG8_BAR; PG8_MMA(0, 0, At, B0); PG8_MMA(0, 1, At, B1); PG8_BAR; PG8_SCHED;
            PG8_LDA(At, 0, 1); PG8_STAGE(PG8_SB(0, 0), b2, voffB); PG8_STAGE(PG8_SB(0, 1), b2 + hstep, voffB); PG8_STAGE(PG8_SA(0, 0), a2, voffA);
            PG8_WAIT_V(8); PG8_WAIT_L(0); PG8_BAR; PG8_MMA(1, 0, At, B0); PG8_MMA(1, 1, At, B1); PG8_BAR; PG8_SCHED;
            PG8_LDB(B0, 1, 0); PG8_LDB(B1, 1, 1); PG8_SCHED; PG8_LDA(At, 1, 0); PG8_STAGE(PG8_SA(0, 1), a2 + hstep, voffA);
            PG8_WAIT_V(8); PG8_WAIT_L(0); PG8_BAR; PG8_MMA(0, 0, At, B0); PG8_MMA(0, 1, At, B1); PG8_BAR; PG8_SCHED;
            PG8_LDA(At, 1, 1); PG8_STAGE(PG8_SB(1, 0), b3, voffB); PG8_STAGE(PG8_SB(1, 1), b3 + hstep, voffB); PG8_STAGE(PG8_SA(1, 0), a3, voffA);
            PG8_WAIT_V(8); PG8_WAIT_L(0); PG8_BAR; PG8_MMA(1, 0, At, B0); PG8_MMA(1, 1, At, B1); PG8_BAR; PG8_SCHED;
            } else {
            PG8_LDB(B0, 0, 0); PG8_SCHED; PG8_LDA(At, 0, 0); PG8_STAGE(PG8_SA(1, 1), a1 + hstep, voffA);
            PG8_WAIT_L(8); PG8_BAR; PG8_WAIT_L(0); PG8_MMA(0, 0, At, B0); PG8_BAR; PG8_SCHED;
            PG8_LDB(B1, 0, 1); PG8_STAGE(PG8_SB(0, 0), b2, voffB);
            PG8_BAR; PG8_WAIT_L(0); PG8_MMA(0, 1, At, B1); PG8_BAR;
            PG8_LDA(At, 0, 1); PG8_STAGE(PG8_SA(0, 0), a2, voffA);
            PG8_BAR; PG8_WAIT_L(0); PG8_MMA(1, 0, At, B0); PG8_BAR; PG8_SCHED;
            PG8_STAGE(PG8_SB(0, 1), b2 + hstep, voffB);
            PG8_WAIT_V(6); PG8_BAR; PG8_MMA(1, 1, At, B1); PG8_BAR;
            PG8_LDB(B0, 1, 0); PG8_SCHED; PG8_LDA(At, 1, 0); PG8_STAGE(PG8_SA(0, 1), a2 + hstep, voffA);
            PG8_WAIT_L(8); PG8_BAR; PG8_WAIT_L(0); PG8_MMA(0, 0, At, B0); PG8_BAR; PG8_SCHED;
            PG8_LDB(B1, 1, 1); PG8_STAGE(PG8_SB(1, 0), b3, voffB);
            PG8_BAR; PG8_WAIT_L(0); PG8_MMA(0, 1, At, B1); PG8_BAR;
            PG8_LDA(At, 1, 1); PG8_STAGE(PG8_SA(1, 0), a3, voffA);
            PG8_BAR; PG8_WAIT_L(0); PG8_MMA(1, 0, At, B0); PG8_BAR; PG8_SCHED;
            PG8_STAGE(PG8_SB(1, 1), b3 + hstep, voffB);
            PG8_WAIT_V(6); PG8_BAR; PG8_MMA(1, 1, At, B1); PG8_BAR;
            }
        }
        if constexpr (ALIGN_EPI) { if (wr == 0) PG8_BAR; }
        if constexpr (!Epi::AFTER_DRAIN) { E(acc, cur, wr, wc, fr, fq); S.done(cur); }
        if (!has_next) break;
#pragma unroll
        for (int a = 0; a < 2; ++a)
#pragma unroll
            for (int b = 0; b < 2; ++b)
#pragma unroll
                for (int m = 0; m < 4; ++m)
#pragma unroll
                    for (int n = 0; n < 2; ++n) acc[a][b][m][n] = (f32x4){0.f, 0.f, 0.f, 0.f};
        cur = nxt; cA = nA; cB = nB; ++ui;
        if constexpr (ALIGN_EPI) { if (wr == 1) PG8_BAR; }
    }
    PG8_WAIT_V(0);
    if constexpr (!ALIGN_EPI) { if (wr == 0) PG8_BAR; }
    PG8_BAR;
    if constexpr (Epi::AFTER_DRAIN) { E.fused(acc, cur, wr, wc, fr, fq, lds, wid, lane); S.done(cur); }
#undef PG8_SA
#undef PG8_SB
#undef PG8_STAGE
#undef PG8_LDA
#undef PG8_LDB
#undef PG8_MMA
#undef PG8_WAIT_V
#undef PG8_WAIT_L
#undef PG8_BAR
#undef PG8_SCHED
}
}

constexpr int DM = 2048, SEQ = 2048, NSEQ = 12, M = NSEQ * SEQ, MP = 8 * SEQ;
constexpr int NIN = 7200, NPROJ = 7424;
constexpr int DFF = 5632, NGU = 2 * DFF;
constexpr int HD = 128, NH = 8;
constexpr float RMS_EPS = 1e-6f, L2_EPS = 1e-6f, QSCALE = 0.08838834764831845f;

constexpr size_t MiB = 1u << 20;
constexpr size_t WS_CTL = 0;
constexpr size_t WS_BA = 1 * MiB;
constexpr size_t WS_WO = 4 * MiB, WS_W1 = 12 * MiB, WS_W3 = 41 * MiB, WS_W4 = 85 * MiB;
constexpr size_t WS_XN = 112 * MiB;
constexpr size_t WS_PROJ = 208 * MiB, PROJ_STRIDE = 48 * MiB;
constexpr size_t WS_O = 352 * MiB;
constexpr size_t WS_PRE = 576 * MiB;
constexpr size_t WS_Z = 720 * MiB;
constexpr size_t WS_ACT = 208 * MiB;
constexpr size_t WS_H16 = 576 * MiB;
constexpr size_t WS_F16 = 672 * MiB;
constexpr size_t WS_END = 768 * MiB;
constexpr size_t WS_SSQ = 256 * 1024;
constexpr float SSQ_SCALE = 1048576.f;

constexpr int RING_OFF = 0, RING_BYTES = 131072;
constexpr int LDSCTL_OFF = 163328, MISC_OFF = LDSCTL_OFF + 320;
constexpr int RSTD_OFF = RING_BYTES;
constexpr int LDS_BYTES = 163840;

#define GAS __attribute__((address_space(1)))
#define LAS __attribute__((address_space(3)))
typedef unsigned short bf16;
typedef unsigned v4u __attribute__((ext_vector_type(4)));
typedef unsigned v2u __attribute__((ext_vector_type(2)));
typedef float f32x4 __attribute__((ext_vector_type(4)));
typedef float f32x2 __attribute__((ext_vector_type(2)));
typedef GAS unsigned gu32;
#define RLX_AGENT __ATOMIC_RELAXED, __HIP_MEMORY_SCOPE_AGENT
#define LDS_WAIT() asm volatile("s_waitcnt lgkmcnt(0)" ::: "memory")
#define VM_WAIT() asm volatile("s_waitcnt vmcnt(0)" ::: "memory")

__device__ __forceinline__ float bf_lo(unsigned v) { return __uint_as_float(v << 16); }
__device__ __forceinline__ float bf_hi(unsigned v) { return __uint_as_float(v & 0xffff0000u); }
__device__ __forceinline__ float bf2f(bf16 b) { return __uint_as_float(((unsigned)b) << 16); }
typedef __bf16 bf16x2_t __attribute__((ext_vector_type(2)));
__device__ __forceinline__ unsigned pk2(float lo, float hi) { bf16x2_t v; v[0] = (__bf16)lo; v[1] = (__bf16)hi; return __builtin_bit_cast(unsigned, v); }
template <int CTRL, int RM> __device__ __forceinline__ float dpp_get(float v) { return __builtin_bit_cast(float, __builtin_amdgcn_update_dpp(0, __builtin_bit_cast(int, v), CTRL, RM, 0xF, false)); }
__device__ __forceinline__ float wave_sum(float v) {
    v += dpp_get<0xB1, 0xF>(v); v += dpp_get<0x4E, 0xF>(v); v += dpp_get<0x141, 0xF>(v); v += dpp_get<0x140, 0xF>(v);
    v += dpp_get<0x142, 0xA>(v); v += dpp_get<0x143, 0xC>(v);
    return __builtin_bit_cast(float, __builtin_amdgcn_readlane(__builtin_bit_cast(int, v), 63));
}
__device__ __forceinline__ float wave_max(float v) {
#pragma unroll
    for (int o = 1; o < 64; o <<= 1) v = fmaxf(v, __shfl_xor(v, o));
    return v;
}
__device__ __forceinline__ float silu_f(float x) { return x * __builtin_amdgcn_rcpf(1.0f + __expf(-x)); }
__device__ __forceinline__ float sigmoid_f(float x) { return 1.0f / (1.0f + expf(-x)); }
__device__ __forceinline__ float softplus_f(float x) { return fmaxf(x, 0.f) + log1pf(expf(-fabsf(x))); }

namespace pg8 {
typedef unsigned u32x2 __attribute__((ext_vector_type(2)));
struct EpiProj {
    static constexpr bool PERM = true, AFTER_DRAIN = false;
    bf16_t* P; size_t stride; bf16_t* Z; float* BA;
    __device__ __forceinline__ void operator()(const f32x4 (&acc)[2][2][4][2], const Unit& u, int wr, int wc, int fr, int fq) const {
        const int row0 = u.pm * BM + wr * 64 + fr;
        if (u.pn < 28) {
            const int t = u.pn >> 2; bf16_t* base = (t < 6) ? P + (size_t)t * stride : Z;
            const int col0 = (u.pn & 3) * BM + wc * 32 + 8 * fq;
#pragma unroll
            for (int ai = 0; ai < 2; ++ai)
#pragma unroll
                for (int m = 0; m < 4; ++m) { bf16_t* rowp = base + (size_t)(row0 + ai * HALF + m * 16) * 1024 + col0;
#pragma unroll
                    for (int bj = 0; bj < 2; ++bj) { const f32x4 v0 = acc[ai][bj][m][0], v1 = acc[ai][bj][m][1];
                        u32x4 w; w.x = cvt_pk_bf16(v0[0], v0[1]); w.y = cvt_pk_bf16(v0[2], v0[3]); w.z = cvt_pk_bf16(v1[0], v1[1]); w.w = cvt_pk_bf16(v1[2], v1[3]);
                        *(u32x4*)(rowp + bj * HALF) = w; } }
        } else if (wc == 0) {
#pragma unroll
            for (int ai = 0; ai < 2; ++ai)
#pragma unroll
                for (int m = 0; m < 4; ++m) { float* rowp = BA + (size_t)(row0 + ai * HALF + m * 16) * 32 + 8 * fq;
                    *(f32x4*)(rowp) = acc[ai][0][m][0]; *(f32x4*)(rowp + 4) = acc[ai][0][m][1]; }
        }
    }
};
struct EpiResid {
    static constexpr bool PERM = true, AFTER_DRAIN = false;
    const float* xp; const float* xs; bf16_t* H; unsigned long long* ssq;
    __device__ __forceinline__ void operator()(const f32x4 (&acc)[2][2][4][2], const Unit& u, int wr, int wc, int fr, int fq) const {
        const int row0 = u.pm * BM + wr * 64 + fr, col0 = u.pn * BM + wc * 32 + 8 * fq;
        const float* xb = (u.pm * BM < MP) ? xp : xs - (size_t)MP * DM;
        float rs[8];
#pragma unroll
        for (int ai = 0; ai < 2; ++ai)
#pragma unroll
            for (int m = 0; m < 4; ++m) { const size_t off = (size_t)(row0 + ai * HALF + m * 16) * DM + col0; float sq = 0.f;
#pragma unroll
                for (int bj = 0; bj < 2; ++bj) { const f32x4 h0 = *(const f32x4*)(xb + off + bj * HALF) + acc[ai][bj][m][0], h1 = *(const f32x4*)(xb + off + bj * HALF + 4) + acc[ai][bj][m][1];
                    sq += ((h0[0] * h0[0] + h0[1] * h0[1]) + (h0[2] * h0[2] + h0[3] * h0[3])) + ((h1[0] * h1[0] + h1[1] * h1[1]) + (h1[2] * h1[2] + h1[3] * h1[3]));
                    u32x4 w; w.x = cvt_pk_bf16(h0[0], h0[1]); w.y = cvt_pk_bf16(h0[2], h0[3]); w.z = cvt_pk_bf16(h1[0], h1[1]); w.w = cvt_pk_bf16(h1[2], h1[3]);
                    *(u32x4*)(H + off + bj * HALF) = w; }
                rs[ai * 4 + m] = sq; }
#pragma unroll
        for (int j = 0; j < 8; ++j) { rs[j] += __shfl_xor(rs[j], 16); rs[j] += __shfl_xor(rs[j], 32); }
        const float v0 = fq == 0 ? rs[0] : fq == 1 ? rs[2] : fq == 2 ? rs[4] : rs[6], v1 = fq == 0 ? rs[1] : fq == 1 ? rs[3] : fq == 2 ? rs[5] : rs[7];
        unsigned long long* q = ssq + (u.pm * BM + (fq >> 1) * HALF + wr * 64 + (fq & 1) * 32 + fr);
        (void)__hip_atomic_fetch_add(q, (unsigned long long)(v0 * SSQ_SCALE + 0.5f), __ATOMIC_RELAXED, __HIP_MEMORY_SCOPE_AGENT);
        (void)__hip_atomic_fetch_add(q + 16, (unsigned long long)(v1 * SSQ_SCALE + 0.5f), __ATOMIC_RELAXED, __HIP_MEMORY_SCOPE_AGENT);
    }
};
struct EpiDown {
    static constexpr bool PERM = true, AFTER_DRAIN = false;
    bf16_t* O;
    __device__ __forceinline__ void operator()(const f32x4 (&acc)[2][2][4][2], const Unit& u, int wr, int wc, int fr, int fq) const {
        const int row0 = u.pm * BM + wr * 64 + fr, col0 = u.pn * BM + wc * 32 + 8 * fq;
#pragma unroll
        for (int ai = 0; ai < 2; ++ai)
#pragma unroll
            for (int m = 0; m < 4; ++m) { bf16_t* rowp = O + (size_t)(row0 + ai * HALF + m * 16) * DM + col0;
#pragma unroll
                for (int bj = 0; bj < 2; ++bj) { const f32x4 v0 = acc[ai][bj][m][0], v1 = acc[ai][bj][m][1];
                    u32x4 w; w.x = cvt_pk_bf16(v0[0], v0[1]); w.y = cvt_pk_bf16(v0[2], v0[3]); w.z = cvt_pk_bf16(v1[0], v1[1]); w.w = cvt_pk_bf16(v1[2], v1[3]);
                    *(u32x4*)(rowp + bj * HALF) = w; } }
    }
};
struct EpiSwiGLU {
    static constexpr bool PERM = true, AFTER_DRAIN = false;
    bf16_t* O; const __attribute__((address_space(3))) float* rs; int g0;
    __device__ __forceinline__ void operator()(const f32x4 (&acc)[2][2][4][2], const Unit& u, int wr, int wc, int fr, int fq) const {
        const int row0 = u.pm * BM + wr * 64 + fr, col0 = u.pn * HALF + wc * 32 + 8 * fq;
        float rv[8];
#pragma unroll
        for (int j = 0; j < 8; ++j) rv[j] = rs[((u.pm >> 3) - g0) * BM + wr * 64 + fr + (j >> 2) * HALF + (j & 3) * 16];
        asm volatile("s_waitcnt lgkmcnt(0)" ::: "memory");
#pragma unroll
        for (int ai = 0; ai < 2; ++ai)
#pragma unroll
            for (int m = 0; m < 4; ++m) { bf16_t* rowp = O + (size_t)(row0 + ai * HALF + m * 16) * DFF + col0;
                const float rstd = rv[ai * 4 + m];
                float r[8];
#pragma unroll
                for (int n = 0; n < 2; ++n)
#pragma unroll
                    for (int j = 0; j < 4; ++j) { const float g = acc[ai][0][m][n][j] * rstd, up = acc[ai][1][m][n][j] * rstd; r[4 * n + j] = g * __builtin_amdgcn_rcpf(1.0f + __expf(-g)) * up; }
                u32x4 w; w.x = cvt_pk_bf16(r[0], r[1]); w.y = cvt_pk_bf16(r[2], r[3]); w.z = cvt_pk_bf16(r[4], r[5]); w.w = cvt_pk_bf16(r[6], r[7]);
                *(u32x4*)rowp = w; }
    }
};
}

#ifndef PG8_SP2
#define PG8_SP2 true
#endif
#ifndef PG8_ALIGN
#define PG8_ALIGN true
#endif

#define XB_TMO      128
#define XB_XCNT(j)  (256  + 64 * (j))
#define XB_XSUB(j)  (1280 + 64 * (j))
#define XB_XGEN(j)  (2304 + 64 * (j))
#define XB_TOP      3328
#define XB_TOPGEN   3392
#define XB_EXIT     3424
#define XCD_BAR_WORDS 3456
#define XB_SPIN_CAP (1u << 18)

__device__ __forceinline__ unsigned xb_ld(unsigned* p)              { return __hip_atomic_load(p, __ATOMIC_RELAXED, __HIP_MEMORY_SCOPE_AGENT); }
__device__ __forceinline__ unsigned xb_add(unsigned* p, unsigned v) { return __hip_atomic_fetch_add(p, v, __ATOMIC_RELAXED, __HIP_MEMORY_SCOPE_AGENT); }
__device__ __forceinline__ unsigned xb_xcc_id() { return (unsigned)__builtin_amdgcn_s_getreg((3 << 11) | 20) & 0xFu; }
#define XB_SPIN(cond, bar) do { unsigned _sp = 0; while (cond) { __builtin_amdgcn_s_sleep(1); \
    if ((++_sp & 255u) == 0u) { if (xb_ld(&(bar)[XB_TMO])) break; if (_sp > XB_SPIN_CAP) { atomicAdd(&(bar)[XB_TMO], 1u); break; } } } } while (0)

struct XcdBarrier {
    unsigned* bar; unsigned x;
    volatile LAS unsigned* st;
};

__device__ __forceinline__ XcdBarrier xcd_barrier_post(unsigned* bar, volatile LAS unsigned* st, const bool t0) {
    XcdBarrier b; b.bar = bar; b.x = xb_xcc_id(); b.st = st;
    if (t0) (void)xb_add(&bar[XB_XCNT(b.x)], 1u);
    return b;
}
__device__ __forceinline__ void xcd_barrier_complete(unsigned* bar, unsigned x, unsigned& nloc, unsigned& nx) {
    const unsigned G = gridDim.x * gridDim.y * gridDim.z;
    unsigned sum, cnt, mine, sp = 0u;
    for (;;) {
        sum = 0u; cnt = 0u; mine = 0u;
#pragma unroll
        for (unsigned j = 0; j < 16; ++j) { const unsigned c = xb_ld(&bar[XB_XCNT(j)]); sum += c; cnt += (c > 0u) ? 1u : 0u; mine = (j == x) ? c : mine; }
        if (sum == G) break;
        __builtin_amdgcn_s_sleep(1);
        if ((++sp & 255u) == 0u) { if (xb_ld(&bar[XB_TMO])) break; if (sp > XB_SPIN_CAP) { atomicAdd(&bar[XB_TMO], 1u); break; } }
    }
    nloc = mine > 0u ? mine : 1u; nx = cnt > 0u ? cnt : 1u;
}

__device__ __forceinline__ void xcd_barrier(const XcdBarrier& b, const bool t0) {
    asm volatile("s_waitcnt vmcnt(0)" ::: "memory");
    __syncthreads();
    if (t0) {
        unsigned* bar = b.bar;
        __builtin_amdgcn_s_waitcnt(0);
        unsigned nloc = b.st[0], nx = b.st[1];
        if (nloc == 0u) { xcd_barrier_complete(bar, b.x, nloc, nx); b.st[0] = nloc; b.st[1] = nx; }
        const unsigned old = xb_add(&bar[XB_XSUB(b.x)], 1u);
        const unsigned gen = old / nloc;
        if (old + 1u == (gen + 1u) * nloc) {
            __builtin_amdgcn_fence(__ATOMIC_RELEASE, "agent");
            asm volatile("s_waitcnt vmcnt(0)" ::: "memory");
            const unsigned og = xb_add(&bar[XB_TOP], 1u);
            const unsigned tg = og / nx;
            if (og + 1u == (tg + 1u) * nx) xb_add(&bar[XB_TOPGEN], 1u);
            else XB_SPIN(xb_ld(&bar[XB_TOPGEN]) == tg, bar);
            __builtin_amdgcn_fence(__ATOMIC_ACQUIRE, "agent");
            xb_add(&bar[XB_XGEN(b.x)], 1u);
            asm volatile("s_waitcnt vmcnt(0)" ::: "memory");
        } else {
            XB_SPIN(xb_ld(&bar[XB_XGEN(b.x)]) == gen, bar);
            __builtin_amdgcn_fence(__ATOMIC_ACQUIRE, "agent");
            asm volatile("s_waitcnt vmcnt(0)" ::: "memory");
        }
    }
    __syncthreads();
}


__device__ unsigned g_xbar[XCD_BAR_WORDS];
__device__ __forceinline__ void xcd_barrier_retire(const XcdBarrier& b, const int lane) {
    unsigned last = 0u;
    if (lane == 0) last = (xb_add(&b.bar[XB_EXIT], 1u) + 1u == gridDim.x * gridDim.y * gridDim.z) ? 1u : 0u;
    last = (unsigned)__builtin_amdgcn_readfirstlane((int)last);
    if (last) for (unsigned i = (unsigned)lane; i < XCD_BAR_WORDS; i += 64u) __hip_atomic_store(&b.bar[i], 0u, __ATOMIC_RELAXED, __HIP_MEMORY_SCOPE_AGENT);
}

struct TrItem { const float* W; const float* ks; bf16* WT; int ldw, ldt, k0, n0, drow; };
__device__ __forceinline__ void tr_load(const TrItem& t, int lane, f32x4 (&v)[8], f32x4 (&kg)[2]) {
    const GAS float* p = (const GAS float*)t.W + (size_t)(t.k0 + (lane >> 3)) * t.ldw + t.n0 + 4 * (lane & 7);
#pragma unroll
    for (int i = 0; i < 8; ++i) v[i] = *(const GAS f32x4*)(p + (size_t)(8 * i) * t.ldw);
    kg[0] = kg[1] = (f32x4){1.f, 1.f, 1.f, 1.f};
    if (t.ks) { const GAS f32x4* kp = (const GAS f32x4*)(t.ks + t.k0 + 8 * (lane & 7)); kg[0] = kp[0]; kg[1] = kp[1]; }
}
__device__ __forceinline__ void tr_store(const TrItem& t, int lane, const f32x4 (&v)[8], const f32x4 (&kg)[2], LAS float* scr) {
    LAS float* w = scr + (lane >> 3) * 33 + 4 * (lane & 7);
#pragma unroll
    for (int i = 0; i < 8; ++i)
#pragma unroll
        for (int e = 0; e < 4; ++e) w[(8 * i) * 33 + e] = v[i][e];
    LDS_WAIT(); asm volatile("" ::: "memory");
    const int c = lane & 7;
#pragma unroll
    for (int j = 0; j < 4; ++j) { const int n = (lane >> 3) + 8 * j; const LAS float* s = scr + (8 * c) * 33 + n;
        v4u o; o.x = pk2(s[0 * 33] * kg[0][0], s[1 * 33] * kg[0][1]); o.y = pk2(s[2 * 33] * kg[0][2], s[3 * 33] * kg[0][3]); o.z = pk2(s[4 * 33] * kg[1][0], s[5 * 33] * kg[1][1]); o.w = pk2(s[6 * 33] * kg[1][2], s[7 * 33] * kg[1][3]);
        *(GAS v4u*)(t.WT + (size_t)(t.drow + n) * t.ldt + t.k0 + 8 * c) = o; }
    LDS_WAIT(); asm volatile("" ::: "memory");
}
__device__ __forceinline__ void rms_row_to_bf16(const float* xrow, const float* w, bf16* orow, int lane) {
    const f32x4* xr = (const f32x4*)xrow + lane; const f32x4* wr = (const f32x4*)w + lane;
    f32x4 v[8]; float s = 0.f;
#pragma unroll
    for (int j = 0; j < 8; ++j) { v[j] = xr[64 * j]; s += (v[j].x * v[j].x + v[j].y * v[j].y) + (v[j].z * v[j].z + v[j].w * v[j].w); }
    const float rstd = rsqrtf(wave_sum(s) * (1.f / DM) + RMS_EPS);
    v2u* o8 = (v2u*)orow + lane;
#pragma unroll
    for (int j = 0; j < 8; ++j) { const f32x4 g = wr[64 * j]; v2u o; o.x = pk2(v[j].x * rstd * g.x, v[j].y * rstd * g.y); o.y = pk2(v[j].z * rstd * g.z, v[j].w * rstd * g.w); o8[64 * j] = o; }
}
__device__ __forceinline__ void rms_row_sum2_to_f32(const bf16* hrow, const bf16* frow, const float* w, float* orow, int lane) {
    const v4u* hr = (const v4u*)hrow + lane; const v4u* fr_ = (const v4u*)frow + lane; const f32x4* wr = (const f32x4*)w;
    float v[4][8]; float s = 0.f;
#pragma unroll
    for (int j = 0; j < 4; ++j) { const v4u q = hr[64 * j], f = fr_[64 * j];
        v[j][0] = bf_lo(q.x) + bf_lo(f.x); v[j][1] = bf_hi(q.x) + bf_hi(f.x); v[j][2] = bf_lo(q.y) + bf_lo(f.y); v[j][3] = bf_hi(q.y) + bf_hi(f.y);
        v[j][4] = bf_lo(q.z) + bf_lo(f.z); v[j][5] = bf_hi(q.z) + bf_hi(f.z); v[j][6] = bf_lo(q.w) + bf_lo(f.w); v[j][7] = bf_hi(q.w) + bf_hi(f.w);
#pragma unroll
        for (int e = 0; e < 8; ++e) s += v[j][e] * v[j][e]; }
    const float rstd = rsqrtf(wave_sum(s) * (1.f / DM) + RMS_EPS);
    f32x4* o4 = (f32x4*)orow;
#pragma unroll
    for (int j = 0; j < 4; ++j) { const int i4 = 2 * (lane + 64 * j); const f32x4 g0 = wr[i4], g1 = wr[i4 + 1];
        o4[i4] = (f32x4){v[j][0] * rstd * g0[0], v[j][1] * rstd * g0[1], v[j][2] * rstd * g0[2], v[j][3] * rstd * g0[3]};
        o4[i4 + 1] = (f32x4){v[j][4] * rstd * g1[0], v[j][5] * rstd * g1[1], v[j][6] * rstd * g1[2], v[j][7] * rstd * g1[3]}; }
}
struct Ptrs {
    const float *xp, *xs, *norm_mix_w, *w_in, *rpb, *conv_w, *A_log, *dt_bias, *dn_norm_w, *w_out, *norm_ffn_w, *w_gate, *w_up, *w_down, *final_norm_w;
    float* out; unsigned char* ws;
};

constexpr int I_1 = (DM / 64) * (NIN / 32), I_O = (DM / 64) * (DM / 32), I_G = (DM / 64) * (DFF / 32), I_D = (DFF / 64) * (DM / 32);
constexpr int IT_W1 = 0, IT_WO = I_1, IT_G = I_1 + I_O, IT_D = I_1 + I_O + 2 * I_G, IT_END = IT_D + I_D;
__device__ __forceinline__ TrItem tr_decode(const Ptrs& P, int r) {
    TrItem t;
    if (r < I_1) { const int nb = r % (NIN / 32), kb = r / (NIN / 32); t.W = P.w_in; t.ks = nullptr; t.ldw = NIN; t.k0 = 64 * kb; t.n0 = 32 * nb; t.WT = (bf16*)(P.ws + WS_W1); t.ldt = DM; t.drow = 32 * nb; return t; } r -= I_1;
    if (r < I_O) { const int nb = r % (DM / 32), kb = r / (DM / 32); t.W = P.w_out; t.ks = nullptr; t.ldw = DM; t.k0 = 64 * kb; t.n0 = 32 * nb; t.WT = (bf16*)(P.ws + WS_WO); t.ldt = DM; t.drow = 32 * nb; return t; } r -= I_O;
    if (r < 2 * I_G) { const int up = r >= I_G; if (up) r -= I_G; const int nb = r % (DFF / 32), kb = r / (DFF / 32); const int n0 = 32 * nb;
        t.W = up ? P.w_up : P.w_gate; t.ks = P.norm_ffn_w; t.ldw = DFF; t.k0 = 64 * kb; t.n0 = n0; t.WT = (bf16*)(P.ws + WS_W3); t.ldt = DM; t.drow = 256 * (n0 >> 7) + (n0 & 127) + (up ? 128 : 0); return t; } r -= 2 * I_G;
    { const int nb = r % (DM / 32), kb = r / (DM / 32); t.W = P.w_down; t.ks = nullptr; t.ldw = DM; t.k0 = 64 * kb; t.n0 = 32 * nb; t.WT = (bf16*)(P.ws + WS_W4); t.ldt = DFF; t.drow = 32 * nb; return t; }
}
__device__ __forceinline__ void wconv_items(const Ptrs& P, LAS unsigned char* lds, int first, int last, int gwi, int ngwi, int wave, int lane) {
    LAS float* scr = (LAS float*)(lds + RING_OFF + wave * 16384);
    int it = first + gwi; if (it >= last) return;
#define WC_CL(i) ((i) < last ? (i) : it)
    TrItem a0 = tr_decode(P, it), b0 = tr_decode(P, WC_CL(it + ngwi)), a1, b1;
    f32x4 va0[8], vb0[8], va1[8], vb1[8], ka0[2], kb0[2], ka1[2], kb1[2];
    tr_load(a0, lane, va0, ka0); tr_load(b0, lane, vb0, kb0);
    for (;;) {
        const int i1 = it + 2 * ngwi; const bool m1 = i1 < last;
        a1 = tr_decode(P, m1 ? i1 : it); b1 = tr_decode(P, (m1 && i1 + ngwi < last) ? i1 + ngwi : (m1 ? i1 : it));
        tr_load(a1, lane, va1, ka1); tr_load(b1, lane, vb1, kb1);
        tr_store(a0, lane, va0, ka0, scr); tr_store(b0, lane, vb0, kb0, scr);
        if (!m1) break;
        const int i2 = i1 + 2 * ngwi; const bool m2 = i2 < last;
        a0 = tr_decode(P, m2 ? i2 : i1); b0 = tr_decode(P, (m2 && i2 + ngwi < last) ? i2 + ngwi : (m2 ? i2 : i1));
        tr_load(a0, lane, va0, ka0); tr_load(b0, lane, vb0, kb0);
        tr_store(a1, lane, va1, ka1, scr); tr_store(b1, lane, vb1, kb1, scr);
        if (!m2) break;
        it = i2;
    }
#undef WC_CL
}
__device__ __forceinline__ void p0_prologue(const Ptrs& P, LAS unsigned char* lds, int gw, int NGW, int wave, int lane) {
    wconv_items(P, lds, IT_W1, IT_WO, gw, NGW, wave, lane);
    bf16* W1t = (bf16*)(P.ws + WS_W1);
    { const v4u z = {0u, 0u, 0u, 0u}; v4u* zp = (v4u*)(W1t + (size_t)NIN * DM);
      for (int i = gw * 64 + lane; i < (NPROJ - NIN) * DM / 8; i += NGW * 64) zp[i] = z; }
    bf16* XN = (bf16*)(P.ws + WS_XN);
    for (int m = gw; m < M; m += NGW) { const float* xr = (m < MP) ? P.xp + (size_t)m * DM : P.xs + (size_t)(m - MP) * DM; rms_row_to_bf16(xr, P.norm_mix_w, XN + (size_t)m * DM, lane); }
}

#define WG_BAR_LDS() do { asm volatile("s_waitcnt lgkmcnt(0)" ::: "memory"); __builtin_amdgcn_s_barrier(); asm volatile("" ::: "memory"); } while (0)
typedef short s16x4 __attribute__((ext_vector_type(4)));
typedef short bf16x8v __attribute__((ext_vector_type(8)));
constexpr int NA_VST = 288, NA_VBUF = 32 * NA_VST;
constexpr float NA_LAZY = 8.0f;
constexpr int NA_KST = 272, NA_KIMG = 32 * NA_KST, NA_VIMG = 32 * NA_VST, NA_BUF = NA_KIMG + NA_VIMG, NA_BT = 4 * NA_BUF;
struct NaGeo { int qb, h, b, rg; };
__device__ __forceinline__ NaGeo na_geo(int task, int G) {
    const int blk = task % G, rnd = task / G, mem = (blk >> 3) & 15, bh = rnd * 16 + (blk & 7) * 2 + (blk >> 7), ty = mem >> 2;
    NaGeo g; g.qb = mem & 3; g.h = bh & 7; g.b = bh >> 3; g.rg = rnd == 4 ? (0xB4 >> (2 * ty)) & 3 : rnd == 5 ? (0x2D >> (2 * ty)) & 3 : (ty + rnd) & 3; return g;
}
__device__ __forceinline__ void na_mfma(const Ptrs& P, LAS unsigned char* lds, int wave, int lane_) {
    const bf16* Q = (const bf16*)(P.ws + WS_PROJ); const bf16* K = (const bf16*)(P.ws + WS_PROJ + PROJ_STRIDE); const bf16* V = (const bf16*)(P.ws + WS_PROJ + 2 * PROJ_STRIDE);
    bf16* Y = (bf16*)(P.ws + WS_XN);
    LAS float* BT = (LAS float*)(lds + NA_BT);
    int bt_head = -1;
    const int G_ = (int)gridDim.x, NTASK = NSEQ * NH * 4 * 4;
    bf16x8v nQf[4]; v4u nsk0, nsv0, nsk1, nsv1;
#define NA_NEXT(ge_) do { int ln_ = lane_; asm volatile("" : "+v"(ln_)); const int t_ = wave * 64 + ln_; const NaGeo e_ = (ge_); \
        const size_t tq_ = (size_t)e_.b * SEQ + (8 * e_.rg + wave) * 64 + 16 * e_.qb + (ln_ & 15); \
        _Pragma("unroll") for (int ks = 0; ks < 4; ++ks) nQf[ks] = *(const bf16x8v*)(Q + tq_ * 1024 + e_.h * HD + 32 * ks + 8 * (ln_ >> 4)); \
        const int kl_ = min(max(8 * e_.rg - 4, 0), 24); \
        const size_t sb_ = ((size_t)e_.b * SEQ + min(max(16 * e_.qb - 8, 0), 32) + (t_ >> 4)) * 1024 + e_.h * HD + 8 * (t_ & 15) + (size_t)kl_ * 64 * 1024; \
        nsk0 = *(const v4u*)(K + sb_); nsv0 = *(const v4u*)(V + sb_); nsk1 = *(const v4u*)(K + sb_ + 64 * 1024); nsv1 = *(const v4u*)(V + sb_ + 64 * 1024); } while (0)
    NaGeo gnext = na_geo((int)blockIdx.x, G_);
    NA_NEXT(gnext);
    for (int task = blockIdx.x; task < NTASK; task += G_) {
        int lane = lane_; asm volatile("" : "+v"(lane));
        const int fr = lane & 15, g = lane >> 4, tid = wave * 64 + lane;
        const NaGeo ge = gnext;
        const int qb = ge.qb, h = ge.h, b = ge.b, rg = ge.rg;
        const bool has_next = task + G_ < NTASK;
        if (has_next) gnext = na_geo(task + G_, G_);
        const int r = 8 * rg + wave, rs = min(max(r - 4, 0), 24), kb0 = min(max(16 * qb - 8, 0), 32);
        const int kr_lo = min(max(8 * rg - 4, 0), 24), kr_hi = min(max(8 * rg + 3, 0), 24) + 7;
        const int c = 16 * qb + fr, cs = min(max(c - 8, 0), 48);
        const size_t tq = (size_t)b * SEQ + r * 64 + c;
        const int skey = tid >> 4, spart = tid & 15;
        const size_t sbase = ((size_t)b * SEQ + kb0 + skey) * 1024 + h * HD + 8 * spart;
        const int kofs = skey * NA_KST + spart * 16, vofs = NA_KIMG + skey * NA_VST + spart * 16;
#define NA_LD(kr_, sk_, sv_) do { const size_t o_ = sbase + (size_t)min((kr_), kr_hi) * 64 * 1024; sk_ = *(const v4u*)(K + o_); sv_ = *(const v4u*)(V + o_); } while (0)
        v4u skPa, svPa, skPb, svPb, skQa, svQa, skQb, svQb;
        NA_LD(kr_lo + 2, skPa, svPa); NA_LD(kr_lo + 3, skPb, svPb); NA_LD(kr_lo + 4, skQa, svQa); NA_LD(kr_lo + 5, skQb, svQb);
        bf16x8v Qf[4];
#pragma unroll
        for (int ks = 0; ks < 4; ++ks) Qf[ks] = nQf[ks];
        const v4u sk0 = nsk0, sv0 = nsv0, sk1 = nsk1, sv1 = nsv1;
        const bool bt_new = (h != bt_head); float bias_in = 0.f;
        if (bt_new && tid < 465) bias_in = P.rpb[h * 465 + tid];
        WG_BAR_LDS();
        *(LAS v4u*)(lds + kofs) = sk0; *(LAS v4u*)(lds + vofs) = sv0; *(LAS v4u*)(lds + NA_BUF + kofs) = sk1; *(LAS v4u*)(lds + NA_BUF + vofs) = sv1;
        if (bt_new && tid < 465) BT[tid] = bias_in;
        bt_head = h;
        f32x4 O[8];
#pragma unroll
        for (int dt = 0; dt < 8; ++dt) O[dt] = (f32x4){0.f, 0.f, 0.f, 0.f};
        float mrun = -INFINITY, lrun = 0.f;
        int bi[8]; bool bv[8];
#pragma unroll
        for (int e = 0; e < 4; ++e) { const int kc0 = kb0 + 4 * g + e, kc1 = kc0 + 16; bv[e] = (kc0 >= cs) && (kc0 < cs + 16); bv[4 + e] = (kc1 >= cs) && (kc1 < cs + 16);
            bi[e] = min(max(kc0 - c + 15, 0), 30); bi[4 + e] = min(max(kc1 - c + 15, 0), 30); }
        WG_BAR_LDS();
#define NA_ROW(kr_) do { const int kr = (kr_); \
            if (kr >= rs && kr < rs + 8) { LAS unsigned char* buf = lds + ((kr - kr_lo) & 3) * NA_BUF; \
                  \
                const unsigned vtr = (unsigned)(size_t)(buf + NA_KIMG) + (unsigned)((4 * g + ((lane & 15) >> 2)) * NA_VST + (lane & 3) * 8); \
                s16x4 lo[8], hi[8]; \
                _Pragma("unroll") for (int d = 0; d < 8; ++d) { \
                    asm volatile("ds_read_b64_tr_b16 %0, %1 offset:%c2" : "=&v"(lo[d]) : "v"(vtr), "i"(d * 32) : "memory"); \
                    asm volatile("ds_read_b64_tr_b16 %0, %1 offset:%c2" : "=&v"(hi[d]) : "v"(vtr), "i"(d * 32 + 16 * NA_VST) : "memory"); } \
                  \
                const unsigned kpa = (unsigned)(size_t)(buf + fr * NA_KST + 16 * g), bra = (unsigned)(size_t)(BT + (kr - r + 7) * 31); \
                bf16x8v kf[8]; float bb[8]; \
                _Pragma("unroll") for (int ks = 0; ks < 4; ++ks) { \
                    asm volatile("ds_read_b128 %0, %1 offset:%c2" : "=&v"(kf[2 * ks]) : "v"(kpa), "i"(64 * ks) : "memory"); \
                    asm volatile("ds_read_b128 %0, %1 offset:%c2" : "=&v"(kf[2 * ks + 1]) : "v"(kpa), "i"(16 * NA_KST + 64 * ks) : "memory"); } \
                _Pragma("unroll") for (int e = 0; e < 8; ++e) asm volatile("ds_read_b32 %0, %1" : "=&v"(bb[e]) : "v"(bra + 4u * (unsigned)bi[e]) : "memory"); \
                asm volatile("s_waitcnt lgkmcnt(0)" ::: "memory"); __builtin_amdgcn_sched_barrier(0); \
                f32x4 s0 = {0.f, 0.f, 0.f, 0.f}, s1 = {0.f, 0.f, 0.f, 0.f}; \
                _Pragma("unroll") for (int ks = 0; ks < 4; ++ks) { s0 = __builtin_amdgcn_mfma_f32_16x16x32_bf16(kf[2 * ks], Qf[ks], s0, 0, 0, 0); \
                    s1 = __builtin_amdgcn_mfma_f32_16x16x32_bf16(kf[2 * ks + 1], Qf[ks], s1, 0, 0, 0); } \
                float mx = -INFINITY; \
                _Pragma("unroll") for (int e = 0; e < 4; ++e) { s0[e] = bv[e] ? s0[e] * QSCALE + bb[e] : -INFINITY; s1[e] = bv[4 + e] ? s1[e] * QSCALE + bb[4 + e] : -INFINITY; mx = fmaxf(mx, fmaxf(s0[e], s1[e])); } \
                if (__builtin_amdgcn_ballot_w64(mx > mrun + NA_LAZY) != 0ull) {          \
                    mx = fmaxf(mx, __shfl_xor(mx, 16)); mx = fmaxf(mx, __shfl_xor(mx, 32)); \
                    const float mnew = fmaxf(mrun, mx), alpha = __expf(mrun - mnew); \
                    lrun *= alpha; mrun = mnew; \
                    _Pragma("unroll") for (int dt = 0; dt < 8; ++dt) O[dt] = O[dt] * alpha; } \
                _Pragma("unroll") for (int e = 0; e < 4; ++e) { s0[e] = __expf(s0[e] - mrun); s1[e] = __expf(s1[e] - mrun); lrun += s0[e] + s1[e]; } \
                v4u pw; pw.x = pk2(s0[0], s0[1]); pw.y = pk2(s0[2], s0[3]); pw.z = pk2(s1[0], s1[1]); pw.w = pk2(s1[2], s1[3]); \
                const bf16x8v Pf = __builtin_bit_cast(bf16x8v, pw); \
                _Pragma("unroll") for (int d = 0; d < 8; ++d) { const bf16x8v Vf = (bf16x8v){lo[d][0], lo[d][1], lo[d][2], lo[d][3], hi[d][0], hi[d][1], hi[d][2], hi[d][3]}; \
                    O[d] = __builtin_amdgcn_mfma_f32_16x16x32_bf16(Vf, Pf, O[d], 0, 0, 0); } \
            } } while (0)
#define NA_DSTEP(k0_, skWa, svWa, skWb, svWb) do { const int k0 = (k0_); \
            if (has_next && k0 <= kr_hi && k0 + 2 > kr_hi) NA_NEXT(gnext);          \
            NA_ROW(k0); NA_ROW(k0 + 1); \
            if (k0 + 2 <= kr_hi) { LAS unsigned char* nb = lds + ((k0 + 2 - kr_lo) & 3) * NA_BUF; *(LAS v4u*)(nb + kofs) = skWa; *(LAS v4u*)(nb + vofs) = svWa; } \
            if (k0 + 3 <= kr_hi) { LAS unsigned char* nb = lds + ((k0 + 3 - kr_lo) & 3) * NA_BUF; *(LAS v4u*)(nb + kofs) = skWb; *(LAS v4u*)(nb + vofs) = svWb; } \
            NA_LD(k0 + 6, skWa, svWa); NA_LD(k0 + 7, skWb, svWb);               \
            WG_BAR_LDS(); } while (0)
#pragma unroll 1
        for (int k4 = kr_lo; k4 <= kr_hi; k4 += 4) {
            NA_DSTEP(k4, skPa, svPa, skPb, svPb); NA_DSTEP(k4 + 2, skQa, svQa, skQb, svQb);
        }
#undef NA_DSTEP
#undef NA_ROW
#undef NA_LD
        lrun += __shfl_xor(lrun, 16); lrun += __shfl_xor(lrun, 32);
        const float inv = 1.0f / lrun;
        bf16* yp = Y + tq * DM + h * HD + 4 * g;
#pragma unroll
        for (int dt = 0; dt < 8; ++dt) { v2u o; o.x = pk2(O[dt][0] * inv, O[dt][1] * inv); o.y = pk2(O[dt][2] * inv, O[dt][3] * inv); *(v2u*)(yp + 16 * dt) = o; }
    }
#undef NA_NEXT
}
typedef float f32x16 __attribute__((ext_vector_type(16)));
constexpr int IST = 272;
constexpr int L_QI = 0, L_KI = 17408, L_VI = 34816, TST = 136, TIMG = 64 * TST;
constexpr size_t WS_EG = 544 * MiB;
constexpr size_t PRE_QF = WS_PRE, PRE_KTF = WS_PRE + 48 * MiB, PRE_QKF = WS_PRE + 96 * MiB;
constexpr size_t OUT_WF = 0, OUT_UF = 96 * MiB;
constexpr int NUNIT = NSEQ * NH * 32;
__device__ __forceinline__ int rowof(int reg, int hh) { return (reg & 3) + 8 * (reg >> 2) + 4 * hh; }
__device__ __forceinline__ f32x16 mfma32(bf16x8v a, bf16x8v b, f32x16 c) { return __builtin_amdgcn_mfma_f32_32x32x16_bf16(a, b, c, 0, 0, 0); }
__device__ __forceinline__ bf16x8v pack8(const float* v) { v4u w; w.x = pk2(v[0], v[1]); w.y = pk2(v[2], v[3]); w.z = pk2(v[4], v[5]); w.w = pk2(v[6], v[7]); return __builtin_bit_cast(bf16x8v, w); }
__device__ __forceinline__ void split8(const float* v, bf16x8v& hi, bf16x8v& lo) {
    float r[8]; v4u w; w.x = pk2(v[0], v[1]); w.y = pk2(v[2], v[3]); w.z = pk2(v[4], v[5]); w.w = pk2(v[6], v[7]); hi = __builtin_bit_cast(bf16x8v, w);
    r[0] = v[0] - bf_lo(w.x); r[1] = v[1] - bf_hi(w.x); r[2] = v[2] - bf_lo(w.y); r[3] = v[3] - bf_hi(w.y); r[4] = v[4] - bf_lo(w.z); r[5] = v[5] - bf_hi(w.z); r[6] = v[6] - bf_lo(w.w); r[7] = v[7] - bf_hi(w.w);
    lo = pack8(r);
}
__device__ __forceinline__ bf16x8v pi_frag(const LAS unsigned char* img, int stride, int row0, int col0, int lane) {
    const LAS unsigned char* p = img + (row0 + (lane & 31)) * stride + (col0 + 4 * (lane >> 5)) * 2;
    const v2u a = *(const LAS v2u*)p, b = *(const LAS v2u*)(p + 16); v4u w; w.x = a.x; w.y = a.y; w.z = b.x; w.w = b.y; return __builtin_bit_cast(bf16x8v, w);
}
__device__ __forceinline__ bf16x8v tr_frag(unsigned img_addr, int stride, int krow0, int col0, int lane) {
    const unsigned a = img_addr + (unsigned)((krow0 + 4 * (lane >> 5) + ((lane & 15) >> 2)) * stride + (col0 + 16 * ((lane >> 4) & 1) + 4 * (lane & 3)) * 2);
    s16x4 lo, hi;
    asm volatile("ds_read_b64_tr_b16 %0, %1" : "=&v"(lo) : "v"(a) : "memory");
    asm volatile("ds_read_b64_tr_b16 %0, %1" : "=&v"(hi) : "v"(a + (unsigned)(8 * stride)) : "memory");
    asm volatile("s_waitcnt lgkmcnt(0)" ::: "memory"); __builtin_amdgcn_sched_barrier(0);
    return (bf16x8v){lo[0], lo[1], lo[2], lo[3], hi[0], hi[1], hi[2], hi[3]};
}
constexpr int P2_SET = 52224, P2_AM = 2 * P2_SET, P2_XT = P2_AM + 16384, P2_VEC = P2_XT + 17408, P2_CW = P2_VEC + 4096;
static_assert(P2_CW + 7680 <= LDSCTL_OFF, "pipelined pre-phase LDS map");
template <bool REV> __device__ __forceinline__ void dn_solve_a(const LAS float* AM, LAS float* XT, float (&x)[32], f32x16& Th, int lane) {
    const int blk = lane >> 5, c = lane & 31, hh = lane >> 5;
#pragma unroll
    for (int i = 0; i < 32; ++i) {
        float acc = (i == c) ? 1.f : 0.f;
        int rofs = (REV ? 63 - 32 * blk - i : 32 * blk + i) * 64;
        if (i >= 3) asm volatile("" : "+v"(rofs) : "v"(x[i - 3]));
        const LAS float* rp = AM + rofs;
#pragma unroll
        for (int qd = 0; qd < (i + 3) / 4; ++qd) {
            const f32x4 a = REV ? *(const LAS f32x4*)(rp + 60 - 32 * blk - 4 * qd) : *(const LAS f32x4*)(rp + 32 * blk + 4 * qd);
#pragma unroll
            for (int e = 0; e < 4; ++e) if (4 * qd + e < i) acc -= (REV ? a[3 - e] : a[e]) * x[4 * qd + e];
        }
        x[i] = acc;
    }
#pragma unroll
    for (int qd = 0; qd < 8; ++qd) *(LAS f32x4*)(XT + lane * 32 + 4 * qd) = (f32x4){x[4 * qd], x[4 * qd + 1], x[4 * qd + 2], x[4 * qd + 3]};
    LDS_WAIT();
    f32x16 Pm;
#pragma unroll
    for (int r = 0; r < 16; ++r) Pm[r] = 0.f;
#pragma unroll
    for (int s = 0; s < 2; ++s) {
        float av[8], bv[8];
        const LAS float* rp = AM + (REV ? 31 - c : 32 + c) * 64;
        if (REV) { const f32x4 alo = *(const LAS f32x4*)(rp + 56 - 16 * s - 8 * hh), ahi = *(const LAS f32x4*)(rp + 60 - 16 * s - 8 * hh);
            av[0] = ahi[3]; av[1] = ahi[2]; av[2] = ahi[1]; av[3] = ahi[0]; av[4] = alo[3]; av[5] = alo[2]; av[6] = alo[1]; av[7] = alo[0]; }
        else { const f32x4 a0 = *(const LAS f32x4*)(rp + 16 * s + 8 * hh), a1 = *(const LAS f32x4*)(rp + 16 * s + 8 * hh + 4);
            av[0] = a0[0]; av[1] = a0[1]; av[2] = a0[2]; av[3] = a0[3]; av[4] = a1[0]; av[5] = a1[1]; av[6] = a1[2]; av[7] = a1[3]; }
        { const f32x4 b0 = *(const LAS f32x4*)(XT + c * 32 + 16 * s + 8 * hh), b1 = *(const LAS f32x4*)(XT + c * 32 + 16 * s + 8 * hh + 4);
            bv[0] = b0[0]; bv[1] = b0[1]; bv[2] = b0[2]; bv[3] = b0[3]; bv[4] = b1[0]; bv[5] = b1[1]; bv[6] = b1[2]; bv[7] = b1[3]; }
        bf16x8v ah, al, bh, bl; split8(av, ah, al); split8(bv, bh, bl);
        Pm = mfma32(ah, bh, Pm); Pm = mfma32(ah, bl, Pm); Pm = mfma32(al, bh, Pm);
    }
#pragma unroll
    for (int r = 0; r < 16; ++r) Th[r] = 0.f;
#pragma unroll
    for (int s = 0; s < 2; ++s) {
        float av[8], pv[8];
#pragma unroll
        for (int j = 0; j < 8; ++j) { const int k = 16 * s + 8 * (j >> 2) + 4 * hh + (j & 3); av[j] = XT[(32 + k) * 32 + c]; pv[j] = Pm[8 * s + j]; }
        bf16x8v ah, al, ph, pl; split8(av, ah, al); split8(pv, ph, pl);
        Th = mfma32(ah, ph, Th); Th = mfma32(ah, pl, Th); Th = mfma32(al, ph, Th);
    }
    LDS_WAIT();
}
template <bool REV> __device__ __forceinline__ void dn_solve_b(const float (&x)[32], const f32x16& Th, const LAS float* BETA, const LAS float* BG, const LAS float* NK, LAS unsigned char* TB, int lane) {
    LAS unsigned char* TBG = TB + TIMG;
    { const v4u z = {0u, 0u, 0u, 0u};
#pragma unroll
      for (int i = 0; i < 17; ++i) *(LAS v4u*)(TB + (lane + 64 * i) * 16) = z; }
    LDS_WAIT();
    const int blk = lane >> 5, c = lane & 31, hh = lane >> 5;
    { const int colo = REV ? 63 - (32 * blk + c) : 32 * blk + c; const float sb = BETA[colo], sg = BG[colo] * NK[colo];
#pragma unroll
        for (int i = 0; i < 32; ++i) { const int rowo = REV ? 63 - (32 * blk + i) : 32 * blk + i;
            *(LAS unsigned short*)(TB + rowo * TST + colo * 2) = (unsigned short)(pk2(x[i] * sb, 0.f) & 0xffffu); *(LAS unsigned short*)(TBG + rowo * TST + colo * 2) = (unsigned short)(pk2(x[i] * sg, 0.f) & 0xffffu); } }
    { const int colo = REV ? 63 - c : c; const float sb = BETA[colo], sg = BG[colo] * NK[colo];
#pragma unroll
        for (int r = 0; r < 16; ++r) { const int i = 32 + rowof(r, hh); const int rowo = REV ? 63 - i : i; const float v = -Th[r];
            *(LAS unsigned short*)(TB + rowo * TST + colo * 2) = (unsigned short)(pk2(v * sb, 0.f) & 0xffffu); *(LAS unsigned short*)(TBG + rowo * TST + colo * 2) = (unsigned short)(pk2(v * sg, 0.f) & 0xffffu); } }
}
__device__ __forceinline__ void dn_pre2(const Ptrs& P, LAS unsigned char* lds, int tid_, int wave, int lane_) {
    const bf16* DNX = (const bf16*)(P.ws + WS_PROJ + 3 * PROJ_STRIDE); const float* BA = (const float*)(P.ws + WS_BA);
    unsigned char* outb = (unsigned char*)P.out;
    const unsigned ldsa = (unsigned)(size_t)lds;
    LAS float* CW = (LAS float*)(lds + P2_CW);
    const int G = gridDim.x; const int u0 = blockIdx.x;
    if (u0 >= NUNIT) return;
    const int hfix = (u0 >> 5) & 7;
    float c_aexp = 0.f, c_dtb = 0.f;
    unsigned xr[3][20]; float ba_b = 0.f, ba_a = 0.f;
#define P2_REQ(un_) do { const int chunk2 = (un_) & 31, h2 = ((un_) >> 5) & 7, b2 = (un_) >> 8; const int t02 = chunk2 * 64; \
        if (wave >= 2 && wave < 6) { _Pragma("unroll") for (int x = 0; x < 3; ++x) { const bf16* X = DNX + (size_t)x * (PROJ_STRIDE / 2) + h2 * HD + 2 * lane; \
            _Pragma("unroll") for (int i = 0; i < 20; ++i) { const int t = t02 + 16 * (wave - 2) - 2 + i; xr[x][i] = (t >= 0 && t < SEQ) ? *(const unsigned*)(X + ((size_t)b2 * SEQ + t) * 1024) : 0u; } } } \
        if (wave >= 6) { const size_t m2 = (size_t)b2 * SEQ + t02 + lane; ba_b = BA[m2 * 32 + (wave - 6) * 8 + h2]; ba_a = BA[m2 * 32 + 16 + (wave - 6) * 8 + h2]; } } while (0)
#define P2_S1T(un_, set_, T0_, T1_, GATES_, REQ_) do { \
        if (wave >= 2 && wave < 6) { \
            _Pragma("unroll") for (int x = 0; x < 3; ++x) { f32x2 cw[5]; \
                _Pragma("unroll") for (int j = 0; j < 5; ++j) cw[j] = *(const LAS f32x2*)(CW + (x * 5 + j) * 128 + 2 * lane); \
                f32x2 xf[20]; _Pragma("unroll") for (int i = (T0_); i < (T1_) + 4; ++i) xf[i] = (f32x2){bf_lo(xr[x][i]), bf_hi(xr[x][i])}; \
                _Pragma("unroll") for (int tt = (T0_); tt < (T1_); ++tt) { f32x2 yy = cw[0] * xf[tt]; \
                    _Pragma("unroll") for (int j = 1; j < 5; ++j) yy = __builtin_elementwise_fma(cw[j], xf[tt + j], yy); \
                    float y0 = yy.x, y1 = yy.y; \
                    y0 = y0 * __builtin_amdgcn_rcpf(1.0f + __expf(-y0)); y1 = y1 * __builtin_amdgcn_rcpf(1.0f + __expf(-y1)); \
                    *(LAS unsigned*)(lds + (set_) * P2_SET + x * 17408 + (16 * (wave - 2) + tt) * IST + 4 * lane) = pk2(y0, y1); } } } \
        if ((GATES_) && wave >= 6) { const int d = wave - 6; LAS float* VEC = (LAS float*)(lds + P2_VEC + (set_) * 2048); \
            const float beta = sigmoid_f(ba_b); float Gs = -c_aexp * softplus_f(ba_a + c_dtb); \
            if (d == 0) { _Pragma("unroll") for (int o = 1; o < 64; o <<= 1) { const float t = __shfl_up(Gs, o); if (lane >= o) Gs += t; } } \
            else { _Pragma("unroll") for (int o = 1; o < 64; o <<= 1) { const float t = __shfl_down(Gs, o); if (lane + o < 64) Gs += t; } } \
            const float eG = expf(Gs); \
            VEC[d * 64 + lane] = beta; VEC[128 + d * 64 + lane] = beta * eG; VEC[256 + d * 64 + lane] = Gs; } \
        if ((REQ_) && (un_) + G < NUNIT) P2_REQ((un_) + G); } while (0)
#define P2_S1(un_, set_) P2_S1T(un_, set_, 0, 16, 1, 1)
    constexpr int P2_TS = 16;
    int lane = lane_, tid = tid_;
    for (int i = tid; i < 3 * 5 * 128; i += 512) { const int x = i / 640, j = (i / 128) % 5, ch = i & 127; CW[i] = P.conv_w[(size_t)j * 3072 + x * 1024 + hfix * HD + ch]; }
    if (wave >= 6) { c_aexp = expf(P.A_log[(wave - 6) * 8 + hfix]); c_dtb = P.dt_bias[(wave - 6) * 8 + hfix]; }
    P2_REQ(u0);
    WG_BAR_LDS();
    P2_S1(u0, 0);
    int it = 0;
    for (int u = u0; u < NUNIT; u += G, ++it) {
        lane = lane_; tid = tid_; asm volatile("" : "+v"(lane), "+v"(tid));
        const int r31 = lane & 31, hh = lane >> 5; const int set = it & 1;
        LAS unsigned char* IMG = lds + set * P2_SET; const unsigned imga = ldsa + set * P2_SET;
        LAS float* VEC = (LAS float*)(lds + P2_VEC + set * 2048);
        LAS float* AM = (LAS float*)(lds + P2_AM);
        WG_BAR_LDS();
        { const int ta = (wave >> 1) & 1, tb = wave & 1;
            const LAS unsigned char* ab = IMG + L_KI + (32 * ta + r31) * IST + 16 * hh; const LAS unsigned char* bb = IMG + (wave < 4 ? L_KI : L_QI) + (32 * tb + r31) * IST + 16 * hh;
            f32x16 acc;
#pragma unroll
            for (int r = 0; r < 16; ++r) acc[r] = 0.f;
#pragma unroll
            for (int s8 = 0; s8 < 8; ++s8) acc = mfma32(*(const LAS bf16x8v*)(ab + 32 * s8), *(const LAS bf16x8v*)(bb + 32 * s8), acc);
            if (wave == 0 || wave == 3 || wave == 4 || wave == 5) {
                f32x16 dq = acc;
                if (wave >= 4) { const LAS unsigned char* qb_ = IMG + L_QI + (32 * (wave - 4) + r31) * IST + 16 * hh;
#pragma unroll
                    for (int r = 0; r < 16; ++r) dq[r] = 0.f;
#pragma unroll
                    for (int s8 = 0; s8 < 8; ++s8) dq = mfma32(*(const LAS bf16x8v*)(qb_ + 32 * s8), *(const LAS bf16x8v*)(qb_ + 32 * s8), dq); }
                float dv = 0.f;
#pragma unroll
                for (int r = 0; r < 16; ++r) if (rowof(r, hh) == r31) dv = dq[r];
                const int trow = (wave >= 4) ? 32 * (wave - 4) : 32 * ta;
                if (((r31 >> 2) & 1) == hh) { const float rn = rsqrtf(dv + L2_EPS); if (wave >= 4) VEC[384 + trow + r31] = rn * QSCALE; else VEC[448 + trow + r31] = rn; }
            }
            WG_BAR_LDS();
            if (wave < 4) {
                const int j = 32 * tb + r31; const float Gj0 = VEC[256 + j], Gj1 = VEC[256 + 64 + j], nkj = VEC[448 + j];
#pragma unroll
                for (int q4 = 0; q4 < 4; ++q4) { const int ib = 32 * ta + 8 * q4 + 4 * hh;
                    const f32x4 be0 = *(const LAS f32x4*)(VEC + ib), be1 = *(const LAS f32x4*)(VEC + 64 + ib), nk4 = *(const LAS f32x4*)(VEC + 448 + ib), g0 = *(const LAS f32x4*)(VEC + 256 + ib), g1 = *(const LAS f32x4*)(VEC + 320 + ib);
#pragma unroll
                    for (int e = 0; e < 4; ++e) { const int i = ib + e; const bool d = i < j;
                        const float v = (d ? be1[e] : be0[e]) * nk4[e] * nkj * acc[4 * q4 + e] * __expf(fminf((d ? g1[e] - Gj1 : g0[e] - Gj0), 0.f));
                        AM[i * 64 + j] = (i == j) ? 0.f : v; } }
                if (wave == 1 || wave == 2) { const int d = wave - 1; const float Gc = VEC[256 + d * 64 + lane], Gl = VEC[256 + d * 64 + (d ? 0 : 63)];
                    float* rec = (float*)(P.ws + WS_EG) + ((size_t)d * NUNIT + u) * 160;
                    rec[lane] = __expf(Gc) * VEC[384 + lane]; rec[64 + lane] = __expf(Gl - Gc) * VEC[448 + lane]; if (lane == 0) rec[128] = __expf(Gl); }
            } else {
                const int cc = 32 * tb + r31; const float nqc = VEC[384 + cc], Gc0 = VEC[256 + cc], Gc1 = VEC[320 + cc];
#pragma unroll
                for (int sf = 0; sf < 2; ++sf) { float v0[8], v1[8];
#pragma unroll
                    for (int jj = 0; jj < 2; ++jj) { const int cb = 32 * ta + 16 * sf + 8 * jj + 4 * hh;
                        const f32x4 nk4 = *(const LAS f32x4*)(VEC + 448 + cb), g0 = *(const LAS f32x4*)(VEC + 256 + cb), g1 = *(const LAS f32x4*)(VEC + 320 + cb);
#pragma unroll
                        for (int e = 0; e < 4; ++e) { const int cp = cb + e; const float a = acc[8 * sf + 4 * jj + e] * nqc * nk4[e];
                            v0[4 * jj + e] = (cp <= cc) ? a * __expf(fminf(Gc0 - g0[e], 0.f)) : 0.f;
                            v1[4 * jj + e] = (cp >= cc) ? a * __expf(fminf(Gc1 - g1[e], 0.f)) : 0.f; } }
                    *(bf16x8v*)(P.ws + PRE_QKF + ((size_t)u) * 8192 + (size_t)((tb * 4 + 2 * ta + sf) * 64 + lane) * 16) = pack8(v0);
                    *(bf16x8v*)(P.ws + PRE_QKF + ((size_t)NUNIT + u) * 8192 + (size_t)((tb * 4 + 2 * ta + sf) * 64 + lane) * 16) = pack8(v1); }
            }
        }
        WG_BAR_LDS();
        float x[32]; f32x16 Th;
        if (wave == 0) dn_solve_a<false>(AM, (LAS float*)(lds + P2_XT), x, Th, lane);
        else if (wave == 1) dn_solve_a<true>(AM, (LAS float*)(lds + P2_XT + 8192), x, Th, lane);
        else if (wave < 6) { if (u + G < NUNIT) P2_S1T(u + G, set ^ 1, 0, P2_TS, 0, 0); }
        else {
            if (u + G < NUNIT) P2_S1T(u + G, set ^ 1, 0, 0, 1, 1);
#pragma unroll
            for (int e = 0; e < 8; ++e) { const int idx = (wave - 6) * 8 + e; const int ct = idx >> 3, s8 = idx & 7; const bf16x8v f = pi_frag(IMG + L_QI, IST, 32 * ct, 16 * s8, lane);
                *(bf16x8v*)(P.ws + PRE_QF + (size_t)u * 16384 + (size_t)(idx * 64 + lane) * 16) = f; }
        }
        WG_BAR_LDS();
        if (wave == 0) dn_solve_b<false>(x, Th, VEC, VEC + 128, VEC + 448, IMG + L_QI, lane);
        else if (wave == 1) dn_solve_b<true>(x, Th, VEC + 64, VEC + 128 + 64, VEC + 448, lds + P2_XT, lane);
        else if (wave < 6) { if (u + G < NUNIT) P2_S1T(u + G, set ^ 1, P2_TS, 16, 0, 1); }
        WG_BAR_LDS();
        { const int kind = wave >> 2, xt = wave & 3;
            bf16x8v xf[4];
#pragma unroll
            for (int s4 = 0; s4 < 4; ++s4) xf[s4] = tr_frag(imga + (kind ? L_KI : L_VI), IST, 16 * s4, 32 * xt, lane);
            if (kind) {
#pragma unroll
                for (int s4 = 0; s4 < 4; ++s4) *(bf16x8v*)(P.ws + PRE_KTF + (size_t)u * 16384 + (size_t)((xt * 4 + s4) * 64 + lane) * 16) = xf[s4]; }
#pragma unroll 1
            for (int dc = 0; dc < 4; ++dc) { const int d = dc >> 1, ct = dc & 1;
                const LAS unsigned char* Ti = (d ? lds + P2_XT : IMG + L_QI) + kind * TIMG;
                f32x16 acc;
#pragma unroll
                for (int r = 0; r < 16; ++r) acc[r] = 0.f;
                if (kind == 0) {
#pragma unroll
                    for (int s4 = 0; s4 < 4; ++s4) acc = mfma32(pi_frag(Ti, TST, 32 * ct, 16 * s4, lane), xf[s4], acc);
                    float v[16];
#pragma unroll
                    for (int r = 0; r < 16; ++r) v[r] = acc[r];
                    bf16x8v* dst = (bf16x8v*)(outb + OUT_UF + ((size_t)d * NUNIT + u) * 16384 + (size_t)((ct * 4 + xt) * 64 + lane) * 32);
                    dst[0] = pack8(v); dst[1] = pack8(v + 8);
                } else {
#pragma unroll
                    for (int s4 = 0; s4 < 4; ++s4) acc = mfma32(xf[s4], pi_frag(Ti, TST, 32 * ct, 16 * s4, lane), acc);
                    float v[16];
#pragma unroll
                    for (int r = 0; r < 16; ++r) v[r] = -acc[r];
                    unsigned char* base = outb + OUT_WF + ((size_t)d * NUNIT + u) * 16384;
                    *(bf16x8v*)(base + (size_t)((ct * 8 + 2 * xt) * 64 + lane) * 16) = pack8(v);
                    *(bf16x8v*)(base + (size_t)((ct * 8 + 2 * xt + 1) * 64 + lane) * 16) = pack8(v + 8);
                }
            }
        }
    }
    WG_BAR_LDS();
#undef P2_REQ
#undef P2_S1
}
constexpr int SC_BUF = 58368, SC_WF = 0, SC_QF = 16384, SC_QKF = 32768, SC_KTF = 40960, SC_EG = 57344;
static_assert(2 * SC_BUF <= LDSCTL_OFF, "scan LDS map");
__device__ __forceinline__ void dn_scan2(const Ptrs& P, LAS unsigned char* lds, int wave, int lane_) {
    const unsigned char* outb = (const unsigned char*)P.out;
    for (int chain = blockIdx.x; chain < NSEQ * NH * 2; chain += gridDim.x) {
        const int d = chain & 1, h = (chain >> 1) & 7, b = chain >> 4;
        if (wave >= 4) {
            const int li = wave - 4;
#pragma unroll 1
            for (int step = -1; step < 32; ++step) {
                if (step + 1 < 32) {
                    int lane = lane_; asm volatile("" : "+v"(lane));
                    const int ci = d ? 31 - (step + 1) : (step + 1); const int u = (b * 8 + h) * 32 + ci; const size_t du = (size_t)d * NUNIT + u;
                    LAS unsigned char* buf = lds + ((step + 1) & 1) * SC_BUF;
                    const unsigned char* gWF = outb + OUT_WF + du * 16384 + lane * 16; const unsigned char* gQF = P.ws + PRE_QF + (size_t)u * 16384 + lane * 16;
                    const unsigned char* gQKF = P.ws + PRE_QKF + du * 8192 + lane * 16; const unsigned char* gKTF = P.ws + PRE_KTF + (size_t)u * 16384 + lane * 16;
#pragma unroll
                    for (int k = 0; k < 4; ++k) { const int j = li + 4 * k;
                        __builtin_amdgcn_global_load_lds((const unsigned*)(gWF + j * 1024), (LAS unsigned*)(buf + SC_WF + j * 1024), 16, 0, 0);
                        __builtin_amdgcn_global_load_lds((const unsigned*)(gQF + j * 1024), (LAS unsigned*)(buf + SC_QF + j * 1024), 16, 0, 0);
                        __builtin_amdgcn_global_load_lds((const unsigned*)(gKTF + j * 1024), (LAS unsigned*)(buf + SC_KTF + j * 1024), 16, 0, 0); }
#pragma unroll
                    for (int k = 0; k < 2; ++k) { const int j = li + 4 * k;
                        __builtin_amdgcn_global_load_lds((const unsigned*)(gQKF + j * 1024), (LAS unsigned*)(buf + SC_QKF + j * 1024), 16, 0, 0); }
                    if (li == 0) __builtin_amdgcn_global_load_lds((const unsigned*)(P.ws + WS_EG + du * 640 + lane * 16), (LAS unsigned*)(buf + SC_EG), 16, 0, 0);
                    asm volatile("s_waitcnt vmcnt(0)" ::: "memory");
                }
                WG_BAR_LDS();
            }
        } else {
            const int dvb = wave;
            f32x16 S[4];
#pragma unroll
            for (int k = 0; k < 4; ++k)
#pragma unroll
                for (int r = 0; r < 16; ++r) S[k][r] = 0.f;
            bf16* Od = (bf16*)(P.ws + WS_O) + (size_t)d * M * 1024;
            v4u un[4];
            { const int ci0 = d ? 31 : 0; const size_t du0 = (size_t)d * NUNIT + (b * 8 + h) * 32 + ci0; const v4u* UF = (const v4u*)(outb + OUT_UF + du0 * 16384);
#pragma unroll
              for (int ct = 0; ct < 2; ++ct) { un[2 * ct] = UF[((ct * 4 + dvb) * 64 + lane_) * 2]; un[2 * ct + 1] = UF[((ct * 4 + dvb) * 64 + lane_) * 2 + 1]; } }
            WG_BAR_LDS();
#pragma unroll 1
            for (int step = 0; step < 32; ++step) {
                int lane = lane_; asm volatile("" : "+v"(lane));
                const int hh = lane >> 5, r31 = lane & 31;
                const int ci = d ? 31 - step : step;
                const LAS unsigned char* buf = lds + (step & 1) * SC_BUF + lane * 16;
                const LAS float* rec = (const LAS float*)(lds + (step & 1) * SC_BUF + SC_EG);
                f32x16 va[2], oa[2];
#pragma unroll
                for (int ct = 0; ct < 2; ++ct) { const v4u u0 = un[2 * ct], u1 = un[2 * ct + 1];
                    va[ct][0] = bf_lo(u0.x); va[ct][1] = bf_hi(u0.x); va[ct][2] = bf_lo(u0.y); va[ct][3] = bf_hi(u0.y); va[ct][4] = bf_lo(u0.z); va[ct][5] = bf_hi(u0.z); va[ct][6] = bf_lo(u0.w); va[ct][7] = bf_hi(u0.w);
                    va[ct][8] = bf_lo(u1.x); va[ct][9] = bf_hi(u1.x); va[ct][10] = bf_lo(u1.y); va[ct][11] = bf_hi(u1.y); va[ct][12] = bf_lo(u1.z); va[ct][13] = bf_hi(u1.z); va[ct][14] = bf_lo(u1.w); va[ct][15] = bf_hi(u1.w);
#pragma unroll
                    for (int r = 0; r < 16; ++r) oa[ct][r] = 0.f; }
                if (step + 1 < 32) { const int cn = d ? 31 - (step + 1) : (step + 1); const size_t dun = (size_t)d * NUNIT + (b * 8 + h) * 32 + cn; const v4u* UF = (const v4u*)(outb + OUT_UF + dun * 16384);
#pragma unroll
                    for (int ct = 0; ct < 2; ++ct) { un[2 * ct] = UF[((ct * 4 + dvb) * 64 + lane) * 2]; un[2 * ct + 1] = UF[((ct * 4 + dvb) * 64 + lane) * 2 + 1]; } }
#pragma unroll
                for (int s8 = 0; s8 < 8; ++s8) { float sv[8];
#pragma unroll
                    for (int j = 0; j < 8; ++j) sv[j] = S[s8 >> 1][8 * (s8 & 1) + j];
                    const bf16x8v Sb = pack8(sv);
#pragma unroll
                    for (int ct = 0; ct < 2; ++ct) { va[ct] = mfma32(*(const LAS bf16x8v*)(buf + SC_WF + (ct * 8 + s8) * 1024), Sb, va[ct]); oa[ct] = mfma32(*(const LAS bf16x8v*)(buf + SC_QF + (ct * 8 + s8) * 1024), Sb, oa[ct]); } }
                bf16x8v vb[4], vs[4];
#pragma unroll
                for (int ct = 0; ct < 2; ++ct) {
#pragma unroll
                    for (int q4 = 0; q4 < 4; ++q4) { const f32x4 eg = *(const LAS f32x4*)(rec + 32 * ct + 8 * q4 + 4 * hh), el = *(const LAS f32x4*)(rec + 64 + 32 * ct + 8 * q4 + 4 * hh);
#pragma unroll
                        for (int e = 0; e < 4; ++e) oa[ct][4 * q4 + e] *= eg[e];
                        if (q4 & 1) { float p[8], sc[8];
#pragma unroll
                            for (int e = 0; e < 4; ++e) { p[4 + e] = va[ct][4 * q4 + e]; sc[4 + e] = p[4 + e] * el[e]; }
                            const f32x4 el0 = *(const LAS f32x4*)(rec + 64 + 32 * ct + 8 * (q4 - 1) + 4 * hh);
#pragma unroll
                            for (int e = 0; e < 4; ++e) { p[e] = va[ct][4 * (q4 - 1) + e]; sc[e] = p[e] * el0[e]; }
                            vb[2 * ct + (q4 >> 1)] = pack8(p); vs[2 * ct + (q4 >> 1)] = pack8(sc); } } }
#pragma unroll
                for (int s4 = 0; s4 < 4; ++s4)
#pragma unroll
                    for (int ct = 0; ct < 2; ++ct) oa[ct] = mfma32(*(const LAS bf16x8v*)(buf + SC_QKF + (ct * 4 + s4) * 1024), vb[s4], oa[ct]);
                const float egl = rec[128];
#pragma unroll
                for (int dkt = 0; dkt < 4; ++dkt) {
#pragma unroll
                    for (int r = 0; r < 16; ++r) S[dkt][r] *= egl;
#pragma unroll
                    for (int s4 = 0; s4 < 4; ++s4) S[dkt] = mfma32(*(const LAS bf16x8v*)(buf + SC_KTF + (dkt * 4 + s4) * 1024), vs[s4], S[dkt]); }
                bf16* op = Od + ((size_t)b * SEQ + ci * 64) * 1024 + h * HD + 32 * dvb + (r31 & ~1);
#pragma unroll
                for (int ct = 0; ct < 2; ++ct)
#pragma unroll
                    for (int r = 0; r < 16; r += 2) { const float a = oa[ct][r], bq = oa[ct][r + 1];
                        const float na = dpp_get<0xB1, 0xF>(a), nb = dpp_get<0xB1, 0xF>(bq);
                        const bool odd = r31 & 1; const unsigned w = odd ? pk2(nb, bq) : pk2(a, na);
                        *(unsigned*)(op + (size_t)(32 * ct + rowof(r + (odd ? 1 : 0), hh)) * 1024) = w; }
                WG_BAR_LDS();
            }
        }
        WG_BAR_LDS();
    }
}
__device__ __forceinline__ float row16_sum(float v) {
    v += dpp_get<0xB1, 0xF>(v); v += dpp_get<0x4E, 0xF>(v); v += dpp_get<0x141, 0xF>(v); v += dpp_get<0x140, 0xF>(v); return v; }
__device__ __forceinline__ void dn_combine(const Ptrs& P, int gw, int NGW, int lane) {
    const bf16* O = (const bf16*)(P.ws + WS_O); const bf16* Z = (const bf16*)(P.ws + WS_Z); bf16* Y = (bf16*)(P.ws + WS_XN);
    const int cl = 8 * (lane & 15);
    const f32x4 nw0 = *(const f32x4*)(P.dn_norm_w + cl), nw1 = *(const f32x4*)(P.dn_norm_w + cl + 4);
    const float nw[8] = {nw0[0], nw0[1], nw0[2], nw0[3], nw1[0], nw1[1], nw1[2], nw1[3]};
    for (int it0 = gw * 2; it0 < M * 2; it0 += NGW * 2) {
        v4u a[2], bq[2], zz[2]; size_t off[2];
#pragma unroll
        for (int k = 0; k < 2; ++k) { const int it = it0 + k, m = it >> 1, hq = it & 1; off[k] = (size_t)m * 1024 + (hq * 4 + (lane >> 4)) * HD + cl;
            a[k] = *(const v4u*)(O + off[k]); bq[k] = *(const v4u*)(O + (size_t)M * 1024 + off[k]); zz[k] = *(const v4u*)(Z + off[k]); }
#pragma unroll
        for (int k = 0; k < 2; ++k) { const int it = it0 + k, m = it >> 1;
            const unsigned aw[4] = {a[k].x, a[k].y, a[k].z, a[k].w}, bw[4] = {bq[k].x, bq[k].y, bq[k].z, bq[k].w}, zw[4] = {zz[k].x, zz[k].y, zz[k].z, zz[k].w};
            float o[8], z[8]; float ss = 0.f;
#pragma unroll
            for (int e = 0; e < 4; ++e) { o[2 * e] = bf_lo(aw[e]) + bf_lo(bw[e]); o[2 * e + 1] = bf_hi(aw[e]) + bf_hi(bw[e]); z[2 * e] = bf_lo(zw[e]); z[2 * e + 1] = bf_hi(zw[e]); ss += o[2 * e] * o[2 * e] + o[2 * e + 1] * o[2 * e + 1]; }
            const float rn = rsqrtf(row16_sum(ss) * (1.0f / HD) + RMS_EPS);
            float y[8];
#pragma unroll
            for (int e = 0; e < 8; ++e) y[e] = o[e] * rn * nw[e] * (z[e] * __builtin_amdgcn_rcpf(1.0f + __expf(-z[e])));
            v4u w; w.x = pk2(y[0], y[1]); w.y = pk2(y[2], y[3]); w.z = pk2(y[4], y[5]); w.w = pk2(y[6], y[7]);
            *(v4u*)(Y + (size_t)m * DM + 1024 + (off[k] - (size_t)m * 1024)) = w; }
    }
}

struct Args { const float* in[15]; float* out; unsigned char* ws; int pad0, pad1; };
typedef const __attribute__((address_space(4))) Args* KArgs;
__device__ __forceinline__ int lane_id_opaque() { int l; asm volatile("v_mbcnt_lo_u32_b32 %0, -1, 0\n\tv_mbcnt_hi_u32_b32 %0, -1, %0" : "=v"(l)); return l; }
__device__ __forceinline__ void load_ptrs(Ptrs& P, KArgs a) {
    asm volatile("" : "+s"(a));
    P.xp = a->in[0]; P.xs = a->in[1]; P.norm_mix_w = a->in[2]; P.w_in = a->in[3]; P.rpb = a->in[4]; P.conv_w = a->in[5]; P.A_log = a->in[6]; P.dt_bias = a->in[7];
    P.dn_norm_w = a->in[8]; P.w_out = a->in[9]; P.norm_ffn_w = a->in[10]; P.w_gate = a->in[11]; P.w_up = a->in[12]; P.w_down = a->in[13]; P.final_norm_w = a->in[14];
    P.out = a->out; P.ws = a->ws;
}
__global__ void __launch_bounds__(512, 2) fwd(Args args) {
    extern __shared__ __attribute__((aligned(16))) unsigned char lds_raw[];
    LAS unsigned char* lds = (LAS unsigned char*)lds_raw;
    const int wave = __builtin_amdgcn_readfirstlane(threadIdx.x >> 6);
    const KArgs ka = (KArgs)__builtin_amdgcn_kernarg_segment_ptr();
    const int G = gridDim.x, NGW = G * 8, gw = blockIdx.x * 8 + wave;
    XcdBarrier bar;
    { const int lane = lane_id_opaque(); const int tid = wave * 64 + lane;
      for (int u = tid; u < (LDS_BYTES - LDSCTL_OFF) / 4; u += 512) ((LAS unsigned*)(lds + LDSCTL_OFF))[u] = 0u;
      __syncthreads();
      bar = xcd_barrier_post(g_xbar, (volatile LAS unsigned*)(lds + MISC_OFF) + 8, tid == 0); }
#define SEAM() do { const int l_ = lane_id_opaque(); xcd_barrier(bar, wave == 0 && l_ == 0); } while (0)
#define PHASE_BEGIN() const int lane = lane_id_opaque(); const int tid = wave * 64 + lane; (void)tid; Ptrs P; load_ptrs(P, ka)

    { PHASE_BEGIN(); p0_prologue(P, lds, gw, NGW, wave, lane);
      for (int i = (int)blockIdx.x * 512 + tid; i < M; i += G * 512) ((unsigned long long*)(P.ws + WS_SSQ))[i] = 0ull; } SEAM();
    { PHASE_BEGIN();
        pg8::Gemm g{(const bf16*)(P.ws + WS_XN), (const bf16*)(P.ws + WS_W1), M, NPROJ, DM}; pg8::StaticOrder S; S.init(M, NPROJ, G, (int)blockIdx.x);
        pg8::EpiProj E{(bf16*)(P.ws + WS_PROJ), PROJ_STRIDE / 2, (bf16*)(P.ws + WS_Z), (float*)(P.ws + WS_BA)};
        pg8::gemm_phase<pg8::EpiProj, pg8::StaticOrder, PG8_ALIGN, PG8_SP2>(lds + RING_OFF, g, S, E, wave, lane);
        { const int rem = S.nwg % G; if (rem && (int)blockIdx.x >= rem) wconv_items(P, lds, IT_WO, IT_G, ((int)blockIdx.x - rem) * 8 + wave, (G - rem) * 8, wave, lane); }
    } SEAM();
    { PHASE_BEGIN(); na_mfma(P, lds, wave, lane); asm volatile("s_waitcnt vmcnt(0)" ::: "memory"); __syncthreads(); }
    { PHASE_BEGIN(); dn_pre2(P, lds, tid, wave, lane); } SEAM();
    { PHASE_BEGIN();
        if ((int)blockIdx.x >= NSEQ * NH * 2) wconv_items(P, lds, IT_G, IT_D, ((int)blockIdx.x - NSEQ * NH * 2) * 8 + wave, (G - NSEQ * NH * 2) * 8, wave, lane);
        else dn_scan2(P, lds, wave, lane);
    } SEAM();
    { PHASE_BEGIN(); dn_combine(P, gw, NGW, lane); } SEAM();
    { PHASE_BEGIN();
        pg8::Gemm g{(const bf16*)(P.ws + WS_XN), (const bf16*)(P.ws + WS_WO), M, DM, DM}; pg8::StaticOrder S; S.init(M, DM, G, (int)blockIdx.x);
        pg8::EpiResid E{P.xp, P.xs, (bf16*)(P.ws + WS_H16), (unsigned long long*)(P.ws + WS_SSQ)};
        pg8::gemm_phase<pg8::EpiResid, pg8::StaticOrder, PG8_ALIGN, PG8_SP2>(lds + RING_OFF, g, S, E, wave, lane);
    } SEAM();
    { PHASE_BEGIN();
        pg8::Gemm g{(const bf16*)(P.ws + WS_H16), (const bf16*)(P.ws + WS_W3), M, NGU, DM}; pg8::StaticOrder S; S.init(M, NGU, G, (int)blockIdx.x);
        pg8::Unit u0; u0.pm = 0; u0.pn = 0; (void)S.next(0, u0);
        LAS float* rsl = (LAS float*)(lds + RSTD_OFF);
        { const int sl = tid >> 7, pm = 8 * ((u0.pm >> 3) + sl) + (u0.pm & 7); unsigned long long* q = (unsigned long long*)(P.ws + WS_SSQ) + (size_t)pm * 256 + (tid & 127);
#pragma unroll
          for (int e = 0; e < 2; ++e) { float r = 0.f;
              if (pm < M / 256) r = rsqrtf((float)__hip_atomic_load(q + 128 * e, __ATOMIC_RELAXED, __HIP_MEMORY_SCOPE_AGENT) * (1.f / (SSQ_SCALE * DM)) + RMS_EPS);
              rsl[sl * 256 + (tid & 127) + 128 * e] = r; } }
        __syncthreads();
        pg8::EpiSwiGLU E{(bf16*)(P.ws + WS_ACT), rsl, u0.pm >> 3};
        pg8::gemm_phase<pg8::EpiSwiGLU, pg8::StaticOrder, PG8_ALIGN, PG8_SP2>(lds + RING_OFF, g, S, E, wave, lane);
        { const int rem = S.nwg % G; if (rem && (int)blockIdx.x >= rem) wconv_items(P, lds, IT_D, IT_END, ((int)blockIdx.x - rem) * 8 + wave, (G - rem) * 8, wave, lane); }
    } SEAM();
    { PHASE_BEGIN();
        pg8::Gemm g{(const bf16*)(P.ws + WS_ACT), (const bf16*)(P.ws + WS_W4), M, DM, DFF}; pg8::StaticOrder S; S.init(M, DM, G, (int)blockIdx.x);
        pg8::EpiDown E{(bf16*)(P.ws + WS_F16)};
        pg8::gemm_phase<pg8::EpiDown, pg8::StaticOrder, PG8_ALIGN, PG8_SP2>(lds + RING_OFF, g, S, E, wave, lane);
    } SEAM();
    { PHASE_BEGIN(); if (wave == 0) xcd_barrier_retire(bar, lane);
      for (int m = gw; m < M; m += NGW) rms_row_sum2_to_f32((const bf16*)(P.ws + WS_H16) + (size_t)m * DM, (const bf16*)(P.ws + WS_F16) + (size_t)m * DM, P.final_norm_w, P.out + (size_t)m * DM, lane); }
#undef SEAM
#undef PHASE_BEGIN
}

extern "C" void kernel_launch(void* const* d_in, const int* in_sizes, int n_in, void* d_out, int out_size, void* d_ws, size_t ws_size, hipStream_t stream) {
    static int grid = 0;
    if (grid == 0) {
        if (n_in != 15 || out_size != M * DM || ws_size < WS_END) { fprintf(stderr, "kernel_launch: unexpected shapes (n_in %d out %d ws %zu)\n", n_in, out_size, ws_size); grid = -1; return; }
        int dev = 0, cus = 0, per_cu = 0;
        if (hipGetDevice(&dev) != hipSuccess || hipDeviceGetAttribute(&cus, hipDeviceAttributeMultiprocessorCount, dev) != hipSuccess) { grid = -1; return; }
        if (cus != 256) { fprintf(stderr, "kernel_launch: built for 256 CUs (one resident 512-thread workgroup each), found %d\n", cus); grid = -1; return; }
        if (hipFuncSetAttribute((const void*)fwd, hipFuncAttributeMaxDynamicSharedMemorySize, LDS_BYTES) != hipSuccess) { grid = -1; return; }
        if (hipOccupancyMaxActiveBlocksPerMultiprocessor(&per_cu, (const void*)fwd, 512, LDS_BYTES) != hipSuccess || per_cu < 1) fprintf(stderr, "kernel_launch: occupancy query says %d\n", per_cu);
        (void)hipGetLastError();
        grid = cus;
    }
    if (grid < 0) return;
    Args a{};
    for (int i = 0; i < 15; ++i) a.in[i] = (const float*)d_in[i];
    a.out = (float*)d_out; a.ws = (unsigned char*)d_ws;
    hipLaunchKernelGGL(fwd, dim3(grid), dim3(512), LDS_BYTES, stream, a);
}
```

```cpp
#include <hip/hip_runtime.h>
#include <cstdio>
#include <cstdint>

namespace pg8 {
#define PG8_LAS __attribute__((address_space(3)))
typedef unsigned short bf16_t;
typedef short bf16x8 __attribute__((ext_vector_type(8)));
typedef float f32x4 __attribute__((ext_vector_type(4)));
typedef unsigned u32x4 __attribute__((ext_vector_type(4)));
constexpr int BM = 256, BK = 64, HALF = 128, HTB = HALF * BK * 2  , STAGE_BYTES = 8 * HTB, NXCD = 8, WGM = 8;

__host__ __device__ __forceinline__ int lds_byte(int r, int c) { const int st = (r >> 4) * 2 + (c >> 5), rr = r & 15, cc = c & 31, ob = rr * 64 + cc * 2; return st * 1024 + (ob ^ (((ob >> 9) & 1) << 5)); }
__host__ __device__ __forceinline__ void stage_rc(int b, int& R, int& C) { const int st = b / 1024, sb = b % 1024, swz = sb ^ (((sb >> 9) & 1) << 5); R = (st >> 1) * 16 + swz / 64; C = (st & 1) * 32 + (swz % 64) / 2; }
__host__ __device__ __forceinline__ int perm32(int rho) { const int n = rho >> 4, i = rho & 15; return 8 * (i >> 2) + 4 * n + (i & 3); }

struct Unit { int pm, pn; };
struct Gemm { const bf16_t* A; const bf16_t* Bt; int M, N, K; };

struct StaticOrder {
    int nM, nN, nwg, G, c;
    __host__ __device__ void init(int M, int N, int G_, int c_) { nM = M / BM; nN = N / BM; nwg = nM * nN; G = G_; c = c_; }
    __host__ __device__ bool next(int i, Unit& u) const {
        const long L = (long)i * G + c; if (L >= nwg) return false;
        int wgid = (int)L; { const int q = nwg / NXCD, r = nwg % NXCD, xcd = wgid % NXCD, off = wgid / NXCD; wgid = (xcd < r ? xcd * (q + 1) : r * (q + 1) + (xcd - r) * q) + off; }
        const int nig = WGM * nN, gid = wgid / nig, fm = gid * WGM, gsz = (nM - fm) < WGM ? (nM - fm) : WGM;
        u.pm = fm + ((wgid % nig) % gsz); u.pn = (wgid % nig) / gsz; return true;
    }
    __device__ __forceinline__ void a_ready(const Unit&) const {}
    __device__ __forceinline__ void done(const Unit&) const {}
};

__device__ __forceinline__ unsigned cvt_pk_bf16(float lo, float hi) { unsigned r; asm volatile("v_cvt_pk_bf16_f32 %0, %1, %2" : "=v"(r) : "v"(lo), "v"(hi)); return r; }
typedef float f32x2 __attribute__((ext_vector_type(2)));
template <class Epi, class Sched, bool ALIGN_EPI = false, bool SP2 = false>
__device__ __forceinline__ void gemm_phase(PG8_LAS unsigned char* lds, const Gemm g, const Sched& S, const Epi& E, const int wid, const int lane) {
    const int tid = wid * 64 + lane, wr = wid >> 2, wc = wid & 3, fr = lane & 15, fq = lane >> 4;
    const int K = g.K, nt = K / BK;
    unsigned voffA[2], voffB[2];
#pragma unroll
    for (int i = 0; i < 2; ++i) { int R, C; stage_rc(tid * 16 + i * 8192, R, C); const int Rb = Epi::PERM ? ((R & ~31) + perm32(R & 31)) : R;
        voffA[i] = (unsigned)(R * K + C) * 2u; voffB[i] = (unsigned)(Rb * K + C) * 2u; }
    const size_t kstep = (size_t)(BK * 2);
    const size_t hstep = (size_t)HALF * K * 2;
    const size_t tstep = 2 * hstep;
    const unsigned ldsw = (unsigned)wid * 1024u;
    const int aoff = lds_byte(wr * 64 + fr, fq * 8), boff = lds_byte(wc * 32 + fr, fq * 8);
#define PG8_SA(b, h) (((b) * 2 + (h)) * HTB)
#define PG8_SB(b, h) ((4 + (b) * 2 + (h)) * HTB)
#define PG8_STAGE(bufoff, gbase, voff) do { _Pragma("unroll") for (int _i = 0; _i < 2; ++_i) \
        __builtin_amdgcn_global_load_lds((const unsigned*)((const char*)(gbase) + (voff)[_i]), (PG8_LAS unsigned*)(lds + (bufoff) + ldsw + _i * 8192), 16, 0, 0); } while (0)
#define PG8_LDA(dst, b, h) do { _Pragma("unroll") for (int m = 0; m < 4; ++m) _Pragma("unroll") for (int k = 0; k < 2; ++k) dst[m][k] = *(const PG8_LAS bf16x8*)(lds + PG8_SA(b, h) + aoff + m * 2048 + k * 1024); } while (0)
#define PG8_LDB(dst, b, h) do { _Pragma("unroll") for (int n = 0; n < 2; ++n) _Pragma("unroll") for (int k = 0; k < 2; ++k) dst[n][k] = *(const PG8_LAS bf16x8*)(lds + PG8_SB(b, h) + boff + n * 2048 + k * 1024); } while (0)
#define PG8_MMA(ai, bj, At, Bt) do { __builtin_amdgcn_s_setprio(1); _Pragma("unroll") for (int m = 0; m < 4; ++m) _Pragma("unroll") for (int n = 0; n < 2; ++n) _Pragma("unroll") for (int k = 0; k < 2; ++k) \
        acc[ai][bj][m][n] = __builtin_amdgcn_mfma_f32_16x16x32_bf16(Bt[n][k], At[m][k], acc[ai][bj][m][n], 0, 0, 0); __builtin_amdgcn_s_setprio(0); } while (0)
#define PG8_WAIT_V(n) asm volatile("s_waitcnt vmcnt(" #n ")" ::: "memory")
#define PG8_WAIT_L(n) asm volatile("s_waitcnt lgkmcnt(" #n ")" ::: "memory")
#define PG8_BAR __builtin_amdgcn_s_barrier()
#define PG8_SCHED __builtin_amdgcn_sched_barrier(0)
    Unit cur, nxt; int ui = 0;
    if (!S.next(0, cur)) return;
    f32x4 acc[2][2][4][2];
#pragma unroll
    for (int a = 0; a < 2; ++a)
#pragma unroll
        for (int b = 0; b < 2; ++b)
#pragma unroll
            for (int m = 0; m < 4; ++m)
#pragma unroll
                for (int n = 0; n < 2; ++n) acc[a][b][m][n] = (f32x4){0.f, 0.f, 0.f, 0.f};
    bf16x8 At[4][2], B0[2][2], B1[2][2];
    const char* cA = (const char*)g.A + (size_t)cur.pm * tstep; const char* cB = (const char*)g.Bt + (size_t)cur.pn * tstep;
    S.a_ready(cur);
    if constexpr (SP2) {
        PG8_STAGE(PG8_SB(0, 0), cB, voffB); PG8_STAGE(PG8_SB(0, 1), cB + hstep, voffB); PG8_STAGE(PG8_SA(0, 0), cA, voffA); PG8_STAGE(PG8_SA(0, 1), cA + hstep, voffA);
        if (wr == 1) PG8_BAR;
        PG8_WAIT_V(2); PG8_BAR;
        PG8_STAGE(PG8_SB(1, 0), cB + kstep, voffB); PG8_STAGE(PG8_SA(1, 0), cA + kstep, voffA); PG8_STAGE(PG8_SB(1, 1), cB + hstep + kstep, voffB);
        PG8_WAIT_V(6); PG8_BAR;
    } else {
        PG8_STAGE(PG8_SB(0, 0), cB, voffB); PG8_STAGE(PG8_SA(0, 0), cA, voffA); PG8_STAGE(PG8_SB(0, 1), cB + hstep, voffB); PG8_STAGE(PG8_SA(0, 1), cA + hstep, voffA);
        if (wr == 1) PG8_BAR;
        PG8_WAIT_V(4); PG8_BAR;
        PG8_STAGE(PG8_SB(1, 0), cB + kstep, voffB); PG8_STAGE(PG8_SA(1, 0), cA + kstep, voffA); PG8_STAGE(PG8_SB(1, 1), cB + hstep + kstep, voffB);
        PG8_WAIT_V(6); PG8_BAR;
    }
    for (;;) {
        const bool has_next = S.next(ui + 1, nxt);
        const char* nA = has_next ? (const char*)g.A + (size_t)nxt.pm * tstep : cA; const char* nB = has_next ? (const char*)g.Bt + (size_t)nxt.pn * tstep : cB;
        for (int t = 0; t < nt; t += 2) {
            const bool last = (t == nt - 2);
            const char* a1 = cA + (size_t)(t + 1) * kstep;
            const char* a2 = last ? nA : cA + (size_t)(t + 2) * kstep; const char* b2 = last ? nB : cB + (size_t)(t + 2) * kstep;
            const char* a3 = a2 + kstep; const char* b3 = b2 + kstep;
            if (last && has_next) S.a_ready(nxt);
            if constexpr (SP2) {
            PG8_LDB(B0, 0, 0); PG8_LDB(B1, 0, 1); PG8_SCHED; PG8_LDA(At, 0, 0); PG8_STAGE(PG8_SA(1, 1), a1 + hstep, voffA);
            PG8_WAIT_V(8); PG8_WAIT_L(0); PG8_BAR; PG8_MMA(0, 0, At, B0); PG8_MMA(0, 1, At, B1); PG8_BAR; PG8_SCHED;
            PG8_LDA(At, 0, 1); PG8_STAGE(PG8_SB(0, 0), b2, voffB); PG8_STAGE(PG8_SB(0, 1), b2 + hstep, voffB); PG8_STAGE(PG8_SA(0, 0), a2, voffA);
            PG8_WAIT_V(8); PG8_WAIT_L(0); PG8_BAR; PG8_MMA(1, 0, At, B0); PG8_MMA(1, 1, At, B1); PG8_BAR; PG8_SCHED;
            PG8_LDB(B0, 1, 0); PG8_LDB(B1, 1, 1); PG8_SCHED; PG8_LDA(At, 1, 0); PG8_STAGE(PG8_SA(0, 1), a2 + hstep, voffA);
            PG8_WAIT_V(8); PG8_WAIT_L(0); PG8_BAR; PG8_MMA(0, 0, At, B0); PG8_MMA(0, 1, At, B1); PG8_BAR; PG8_SCHED;
            PG8_LDA(At, 1, 1); PG8_STAGE(PG8_SB(1, 0), b3, voffB); PG8_STAGE(PG8_SB(1, 1), b3 + hstep, voffB); PG8_STAGE(PG8_SA(1, 0), a3, voffA);
            PG8_WAIT_V(8); PG8_WAIT_L(0); PG8_BAR; PG8_MMA(1, 0, At, B0); PG8_MMA(1, 1, At, B1); PG8_BAR; PG8_SCHED;
            } else {
            PG8_LDB(B0, 0, 0); PG8_SCHED; PG8_LDA(At, 0, 0); PG8_STAGE(PG8_SA(1, 1), a1 + hstep, voffA);
            PG8_WAIT_L(8); PG8_BAR; PG8_WAIT_L(0); PG8_MMA(0, 0, At, B0); PG8_BAR; PG8_SCHED;
            PG8_LDB(B1, 0, 1); PG8_STAGE(PG8_SB(0, 0), b2, voffB);
            PG8_BAR; PG8_WAIT_L(0); PG8_MMA(0, 1, At, B1); PG8_BAR;
            PG8_LDA(At, 0, 1); PG8_STAGE(PG8_SA(0, 0), a2, voffA);
            PG8_BAR; PG8_WAIT_L(0); PG8_MMA(1, 0, At, B0); PG8_BAR; PG8_SCHED;
            PG8_STAGE(PG8_SB(0, 1), b2 + hstep, voffB);
            PG8_WAIT_V(6); PG8_BAR; PG8_MMA(1, 1, At, B1); PG8_BAR;
            PG8_LDB(B0, 1, 0); PG8_SCHED; PG8_LDA(At, 1, 0); PG8_STAGE(PG8_SA(0, 1), a2 + hstep, voffA);
            PG8_WAIT_L(8); PG8_BAR; PG8_WAIT_L(0); PG8_MMA(0, 0, At, B0); PG8_BAR; PG8_SCHED;
            PG8_LDB(B1, 1, 1); PG8_STAGE(PG8_SB(1, 0), b3, voffB);
            PG8_BAR; PG8_WAIT_L(0); PG8_MMA(0, 1, At, B1); PG8_BAR;
            PG8_LDA(At, 1, 1); PG8_STAGE(PG8_SA(1, 0), a3, voffA);
            PG8_BAR; PG8_WAIT_L(0); PG8_MMA(1, 0, At, B0); PG8_BAR; PG8_SCHED;
            PG8_STAGE(PG8_SB(1, 1), b3 + hstep, voffB);
            PG8_WAIT_V(6); PG8_BAR; PG8_MMA(1, 1, At, B1); PG8_BAR;
            }
        }
        if constexpr (ALIGN_EPI) { if (wr == 0) PG8_BAR; }
        if constexpr (!Epi::AFTER_DRAIN) { E(acc, cur, wr, wc, fr, fq); S.done(cur); }
        if (!has_next) break;
#pragma unroll
        for (int a = 0; a < 2; ++a)
#pragma unroll
            for (int b = 0; b < 2; ++b)
#pragma unroll
                for (int m = 0; m < 4; ++m)
#pragma unroll
                    for (int n = 0; n < 2; ++n) acc[a][b][m][n] = (f32x4){0.f, 0.f, 0.f, 0.f};
        cur = nxt; cA = nA; cB = nB; ++ui;
        if constexpr (ALIGN_EPI) { if (wr == 1) PG8_BAR; }
    }
    PG8_WAIT_V(0);
    if constexpr (!ALIGN_EPI) { if (wr == 0) PG8_BAR; }
    PG8_BAR;
    if constexpr (Epi::AFTER_DRAIN) { E.fused(acc, cur, wr, wc, fr, fq, lds, wid, lane); S.done(cur); }
#undef PG8_SA
#undef PG8_SB
#undef PG8_STAGE
#undef PG8_LDA
#undef PG8_LDB
#undef PG8_MMA
#undef PG8_WAIT_V
#undef PG8_WAIT_L
#undef PG8_BAR
#undef PG8_SCHED
}
}

constexpr int DM = 2048, SEQ = 2048, NSEQ = 12, M = NSEQ * SEQ, MP = 8 * SEQ;
constexpr int NIN = 7200, NPROJ = 7424;
constexpr int DFF = 5632, NGU = 2 * DFF;
constexpr int HD = 128, NH = 8;
constexpr float RMS_EPS = 1e-6f, L2_EPS = 1e-6f, QSCALE = 0.08838834764831845f;

constexpr size_t MiB = 1u << 20;
constexpr size_t WS_CTL = 0;
constexpr size_t WS_BA = 1 * MiB;
constexpr size_t WS_WO = 4 * MiB, WS_W1 = 12 * MiB, WS_W3 = 41 * MiB, WS_W4 = 85 * MiB;
constexpr size_t WS_XN = 112 * MiB;
constexpr size_t WS_PROJ = 208 * MiB, PROJ_STRIDE = 48 * MiB;
constexpr size_t WS_O = 352 * MiB;
constexpr size_t WS_PRE = 576 * MiB;
constexpr size_t WS_Z = 720 * MiB;
constexpr size_t WS_ACT = 208 * MiB;
constexpr size_t WS_H16 = 576 * MiB;
constexpr size_t WS_F16 = 672 * MiB;
constexpr size_t WS_END = 768 * MiB;
constexpr size_t WS_SSQ = 256 * 1024;
constexpr float SSQ_SCALE = 1048576.f;

constexpr int RING_OFF = 0, RING_BYTES = 131072;
constexpr int LDSCTL_OFF = 163328, MISC_OFF = LDSCTL_OFF + 320;
constexpr int RSTD_OFF = RING_BYTES;
constexpr int LDS_BYTES = 163840;

#define GAS __attribute__((address_space(1)))
#define LAS __attribute__((address_space(3)))
typedef unsigned short bf16;
typedef unsigned v4u __attribute__((ext_vector_type(4)));
typedef unsigned v2u __attribute__((ext_vector_type(2)));
typedef float f32x4 __attribute__((ext_vector_type(4)));
typedef float f32x2 __attribute__((ext_vector_type(2)));
typedef GAS unsigned gu32;
#define RLX_AGENT __ATOMIC_RELAXED, __HIP_MEMORY_SCOPE_AGENT
#define LDS_WAIT() asm volatile("s_waitcnt lgkmcnt(0)" ::: "memory")
#define VM_WAIT() asm volatile("s_waitcnt vmcnt(0)" ::: "memory")

__device__ __forceinline__ float bf_lo(unsigned v) { return __uint_as_float(v << 16); }
__device__ __forceinline__ float bf_hi(unsigned v) { return __uint_as_float(v & 0xffff0000u); }
__device__ __forceinline__ float bf2f(bf16 b) { return __uint_as_float(((unsigned)b) << 16); }
typedef __bf16 bf16x2_t __attribute__((ext_vector_type(2)));
__device__ __forceinline__ unsigned pk2(float lo, float hi) { bf16x2_t v; v[0] = (__bf16)lo; v[1] = (__bf16)hi; return __builtin_bit_cast(unsigned, v); }
template <int CTRL, int RM> __device__ __forceinline__ float dpp_get(float v) { return __builtin_bit_cast(float, __builtin_amdgcn_update_dpp(0, __builtin_bit_cast(int, v), CTRL, RM, 0xF, false)); }
__device__ __forceinline__ float wave_sum(float v) {
    v += dpp_get<0xB1, 0xF>(v); v += dpp_get<0x4E, 0xF>(v); v += dpp_get<0x141, 0xF>(v); v += dpp_get<0x140, 0xF>(v);
    v += dpp_get<0x142, 0xA>(v); v += dpp_get<0x143, 0xC>(v);
    return __builtin_bit_cast(float, __builtin_amdgcn_readlane(__builtin_bit_cast(int, v), 63));
}
__device__ __forceinline__ float wave_max(float v) {
#pragma unroll
    for (int o = 1; o < 64; o <<= 1) v = fmaxf(v, __shfl_xor(v, o));
    return v;
}
__device__ __forceinline__ float silu_f(float x) { return x * __builtin_amdgcn_rcpf(1.0f + __expf(-x)); }
__device__ __forceinline__ float sigmoid_f(float x) { return 1.0f / (1.0f + expf(-x)); }
__device__ __forceinline__ float softplus_f(float x) { return fmaxf(x, 0.f) + log1pf(expf(-fabsf(x))); }

namespace pg8 {
typedef unsigned u32x2 __attribute__((ext_vector_type(2)));
struct EpiProj {
    static constexpr bool PERM = true, AFTER_DRAIN = false;
    bf16_t* P; size_t stride; bf16_t* Z; float* BA;
    __device__ __forceinline__ void operator()(const f32x4 (&acc)[2][2][4][2], const Unit& u, int wr, int wc, int fr, int fq) const {
        const int row0 = u.pm * BM + wr * 64 + fr;
        if (u.pn < 28) {
            const int t = u.pn >> 2; bf16_t* base = (t < 6) ? P + (size_t)t * stride : Z;
            const int col0 = (u.pn & 3) * BM + wc * 32 + 8 * fq;
#pragma unroll
            for (int ai = 0; ai < 2; ++ai)
#pragma unroll
                for (int m = 0; m < 4; ++m) { bf16_t* rowp = base + (size_t)(row0 + ai * HALF + m * 16) * 1024 + col0;
#pragma unroll
                    for (int bj = 0; bj < 2; ++bj) { const f32x4 v0 = acc[ai][bj][m][0], v1 = acc[ai][bj][m][1];
                        u32x4 w; w.x = cvt_pk_bf16(v0[0], v0[1]); w.y = cvt_pk_bf16(v0[2], v0[3]); w.z = cvt_pk_bf16(v1[0], v1[1]); w.w = cvt_pk_bf16(v1[2], v1[3]);
                        *(u32x4*)(rowp + bj * HALF) = w; } }
        } else if (wc == 0) {
#pragma unroll
            for (int ai = 0; ai < 2; ++ai)
#pragma unroll
                for (int m = 0; m < 4; ++m) { float* rowp = BA + (size_t)(row0 + ai * HALF + m * 16) * 32 + 8 * fq;
                    *(f32x4*)(rowp) = acc[ai][0][m][0]; *(f32x4*)(rowp + 4) = acc[ai][0][m][1]; }
        }
    }
};
struct EpiResid {
    static constexpr bool PERM = true, AFTER_DRAIN = false;
    const float* xp; const float* xs; bf16_t* H; unsigned long long* ssq;
    __device__ __forceinline__ void operator()(const f32x4 (&acc)[2][2][4][2], const Unit& u, int wr, int wc, int fr, int fq) const {
        const int row0 = u.pm * BM + wr * 64 + fr, col0 = u.pn * BM + wc * 32 + 8 * fq;
        const float* xb = (u.pm * BM < MP) ? xp : xs - (size_t)MP * DM;
        float rs[8];
#pragma unroll
        for (int ai = 0; ai < 2; ++ai)
#pragma unroll
            for (int m = 0; m < 4; ++m) { const size_t off = (size_t)(row0 + ai * HALF + m * 16) * DM + col0; float sq = 0.f;
#pragma unroll
                for (int bj = 0; bj < 2; ++bj) { const f32x4 h0 = *(const f32x4*)(xb + off + bj * HALF) + acc[ai][bj][m][0], h1 = *(const f32x4*)(xb + off + bj * HALF + 4) + acc[ai][bj][m][1];
                    sq += ((h0[0] * h0[0] + h0[1] * h0[1]) + (h0[2] * h0[2] + h0[3] * h0[3])) + ((h1[0] * h1[0] + h1[1] * h1[1]) + (h1[2] * h1[2] + h1[3] * h1[3]));
                    u32x4 w; w.x = cvt_pk_bf16(h0[0], h0[1]); w.y = cvt_pk_bf16(h0[2], h0[3]); w.z = cvt_pk_bf16(h1[0], h1[1]); w.w = cvt_pk_bf16(h1[2], h1[3]);
                    *(u32x4*)(H + off + bj * HALF) = w; }
                rs[ai * 4 + m] = sq; }
#pragma unroll
        for (int j = 0; j < 8; ++j) { rs[j] += __shfl_xor(rs[j], 16); rs[j] += __shfl_xor(rs[j], 32); }
        const float v0 = fq == 0 ? rs[0] : fq == 1 ? rs[2] : fq == 2 ? rs[4] : rs[6], v1 = fq == 0 ? rs[1] : fq == 1 ? rs[3] : fq == 2 ? rs[5] : rs[7];
        unsigned long long* q = ssq + (u.pm * BM + (fq >> 1) * HALF + wr * 64 + (fq & 1) * 32 + fr);
        (void)__hip_atomic_fetch_add(q, (unsigned long long)(v0 * SSQ_SCALE + 0.5f), __ATOMIC_RELAXED, __HIP_MEMORY_SCOPE_AGENT);
        (void)__hip_atomic_fetch_add(q + 16, (unsigned long long)(v1 * SSQ_SCALE + 0.5f), __ATOMIC_RELAXED, __HIP_MEMORY_SCOPE_AGENT);
    }
};
struct EpiDown {
    static constexpr bool PERM = true, AFTER_DRAIN = false;
    bf16_t* O;
    __device__ __forceinline__ void operator()(const f32x4 (&acc)[2][2][4][2], const Unit& u, int wr, int wc, int fr, int fq) const {
        const int row0 = u.pm * BM + wr * 64 + fr, col0 = u.pn * BM + wc * 32 + 8 * fq;
#pragma unroll
        for (int ai = 0; ai < 2; ++ai)
#pragma unroll
            for (int m = 0; m < 4; ++m) { bf16_t* rowp = O + (size_t)(row0 + ai * HALF + m * 16) * DM + col0;
#pragma unroll
                for (int bj = 0; bj < 2; ++bj) { const f32x4 v0 = acc[ai][bj][m][0], v1 = acc[ai][bj][m][1];
                    u32x4 w; w.x = cvt_pk_bf16(v0[0], v0[1]); w.y = cvt_pk_bf16(v0[2], v0[3]); w.z = cvt_pk_bf16(v1[0], v1[1]); w.w = cvt_pk_bf16(v1[2], v1[3]);
                    *(u32x4*)(rowp + bj * HALF) = w; } }
    }
};
struct EpiSwiGLU {
    static constexpr bool PERM = true, AFTER_DRAIN = false;
    bf16_t* O; const __attribute__((address_space(3))) float* rs; int g0;
    __device__ __forceinline__ void operator()(const f32x4 (&acc)[2][2][4][2], const Unit& u, int wr, int wc, int fr, int fq) const {
        const int row0 = u.pm * BM + wr * 64 + fr, col0 = u.pn * HALF + wc * 32 + 8 * fq;
        float rv[8];
#pragma unroll
        for (int j = 0; j < 8; ++j) rv[j] = rs[((u.pm >> 3) - g0) * BM + wr * 64 + fr + (j >> 2) * HALF + (j & 3) * 16];
        asm volatile("s_waitcnt lgkmcnt(0)" ::: "memory");
#pragma unroll
        for (int ai = 0; ai < 2; ++ai)
#pragma unroll
            for (int m = 0; m < 4; ++m) { bf16_t* rowp = O + (size_t)(row0 + ai * HALF + m * 16) * DFF + col0;
                const float rstd = rv[ai * 4 + m];
                float r[8];
#pragma unroll
                for (int n = 0; n < 2; ++n)
#pragma unroll
                    for (int j = 0; j < 4; ++j) { const float g = acc[ai][0][m][n][j] * rstd, up = acc[ai][1][m][n][j] * rstd; r[4 * n + j] = g * __builtin_amdgcn_rcpf(1.0f + __expf(-g)) * up; }
                u32x4 w; w.x = cvt_pk_bf16(r[0], r[1]); w.y = cvt_pk_bf16(r[2], r[3]); w.z = cvt_pk_bf16(r[4], r[5]); w.w = cvt_pk_bf16(r[6], r[7]);
                *(u32x4*)rowp = w; }
    }
};
}

#ifndef PG8_SP2
#define PG8_SP2 true
#endif
#ifndef PG8_ALIGN
#define PG8_ALIGN true
#endif

#define XB_TMO      128
#define XB_XCNT(j)  (256  + 64 * (j))
#define XB_XSUB(j)  (1280 + 64 * (j))
#define XB_XGEN(j)  (2304 + 64 * (j))
#define XB_TOP      3328
#define XB_TOPGEN   3392
#define XB_EXIT     3424
#define XCD_BAR_WORDS 3456
#define XB_SPIN_CAP (1u << 18)

__device__ __forceinline__ unsigned xb_ld(unsigned* p)              { return __hip_atomic_load(p, __ATOMIC_RELAXED, __HIP_MEMORY_SCOPE_AGENT); }
__device__ __forceinline__ unsigned xb_add(unsigned* p, unsigned v) { return __hip_atomic_fetch_add(p, v, __ATOMIC_RELAXED, __HIP_MEMORY_SCOPE_AGENT); }
__device__ __forceinline__ unsigned xb_xcc_id() { return (unsigned)__builtin_amdgcn_s_getreg((3 << 11) | 20) & 0xFu; }
#define XB_SPIN(cond, bar) do { unsigned _sp = 0; while (cond) { __builtin_amdgcn_s_sleep(1); \
    if ((++_sp & 255u) == 0u) { if (xb_ld(&(bar)[XB_TMO])) break; if (_sp > XB_SPIN_CAP) { atomicAdd(&(bar)[XB_TMO], 1u); break; } } } } while (0)

struct XcdBarrier {
    unsigned* bar; unsigned x;
    volatile LAS unsigned* st;
};

__device__ __forceinline__ XcdBarrier xcd_barrier_post(unsigned* bar, volatile LAS unsigned* st, const bool t0) {
    XcdBarrier b; b.bar = bar; b.x = xb_xcc_id(); b.st = st;
    if (t0) (void)xb_add(&bar[XB_XCNT(b.x)], 1u);
    return b;
}
__device__ __forceinline__ void xcd_barrier_complete(unsigned* bar, unsigned x, unsigned& nloc, unsigned& nx) {
    const unsigned G = gridDim.x * gridDim.y * gridDim.z;
    unsigned sum, cnt, mine, sp = 0u;
    for (;;) {
        sum = 0u; cnt = 0u; mine = 0u;
#pragma unroll
        for (unsigned j = 0; j < 16; ++j) { const unsigned c = xb_ld(&bar[XB_XCNT(j)]); sum += c; cnt += (c > 0u) ? 1u : 0u; mine = (j == x) ? c : mine; }
        if (sum == G) break;
        __builtin_amdgcn_s_sleep(1);
        if ((++sp & 255u) == 0u) { if (xb_ld(&bar[XB_TMO])) break; if (sp > XB_SPIN_CAP) { atomicAdd(&bar[XB_TMO], 1u); break; } }
    }
    nloc = mine > 0u ? mine : 1u; nx = cnt > 0u ? cnt : 1u;
}

__device__ __forceinline__ void xcd_barrier(const XcdBarrier& b, const bool t0) {
    asm volatile("s_waitcnt vmcnt(0)" ::: "memory");
    __syncthreads();
    if (t0) {
        unsigned* bar = b.bar;
        __builtin_amdgcn_s_waitcnt(0);
        unsigned nloc = b.st[0], nx = b.st[1];
        if (nloc == 0u) { xcd_barrier_complete(bar, b.x, nloc, nx); b.st[0] = nloc; b.st[1] = nx; }
        const unsigned old = xb_add(&bar[XB_XSUB(b.x)], 1u);
        const unsigned gen = old / nloc;
        if (old + 1u == (gen + 1u) * nloc) {
            __builtin_amdgcn_fence(__ATOMIC_RELEASE, "agent");
            asm volatile("s_waitcnt vmcnt(0)" ::: "memory");
            const unsigned og = xb_add(&bar[XB_TOP], 1u);
            const unsigned tg = og / nx;
            if (og + 1u == (tg + 1u) * nx) {
#pragma unroll
                for (unsigned j = 0; j < 16; ++j) (void)xb_add(&bar[XB_XGEN(j)], 1u);
            }
        }
        XB_SPIN(xb_ld(&bar[XB_XGEN(b.x)]) == gen, bar);
        __builtin_amdgcn_fence(__ATOMIC_ACQUIRE, "agent");
        asm volatile("s_waitcnt vmcnt(0)" ::: "memory");
    }
    __syncthreads();
}


__device__ unsigned g_xbar[XCD_BAR_WORDS];
__device__ __forceinline__ void xcd_barrier_retire(const XcdBarrier& b, const int lane) {
    unsigned last = 0u;
    if (lane == 0) last = (xb_add(&b.bar[XB_EXIT], 1u) + 1u == gridDim.x * gridDim.y * gridDim.z) ? 1u : 0u;
    last = (unsigned)__builtin_amdgcn_readfirstlane((int)last);
    if (last) for (unsigned i = (unsigned)lane; i < XCD_BAR_WORDS; i += 64u) __hip_atomic_store(&b.bar[i], 0u, __ATOMIC_RELAXED, __HIP_MEMORY_SCOPE_AGENT);
}

struct TrItem { const float* W; const float* ks; bf16* WT; int ldw, ldt, k0, n0, drow; };
__device__ __forceinline__ void tr_load(const TrItem& t, int lane, f32x4 (&v)[8], f32x4 (&kg)[2]) {
    const GAS float* p = (const GAS float*)t.W + (size_t)(t.k0 + (lane >> 3)) * t.ldw + t.n0 + 4 * (lane & 7);
#pragma unroll
    for (int i = 0; i < 8; ++i) v[i] = *(const GAS f32x4*)(p + (size_t)(8 * i) * t.ldw);
    kg[0] = kg[1] = (f32x4){1.f, 1.f, 1.f, 1.f};
    if (t.ks) { const GAS f32x4* kp = (const GAS f32x4*)(t.ks + t.k0 + 8 * (lane & 7)); kg[0] = kp[0]; kg[1] = kp[1]; }
}
__device__ __forceinline__ void tr_store(const TrItem& t, int lane, const f32x4 (&v)[8], const f32x4 (&kg)[2], LAS float* scr) {
    LAS float* w = scr + (lane >> 3) * 33 + 4 * (lane & 7);
#pragma unroll
    for (int i = 0; i < 8; ++i)
#pragma unroll
        for (int e = 0; e < 4; ++e) w[(8 * i) * 33 + e] = v[i][e];
    LDS_WAIT(); asm volatile("" ::: "memory");
    const int c = lane & 7;
#pragma unroll
    for (int j = 0; j < 4; ++j) { const int n = (lane >> 3) + 8 * j; const LAS float* s = scr + (8 * c) * 33 + n;
        v4u o; o.x = pk2(s[0 * 33] * kg[0][0], s[1 * 33] * kg[0][1]); o.y = pk2(s[2 * 33] * kg[0][2], s[3 * 33] * kg[0][3]); o.z = pk2(s[4 * 33] * kg[1][0], s[5 * 33] * kg[1][1]); o.w = pk2(s[6 * 33] * kg[1][2], s[7 * 33] * kg[1][3]);
        *(GAS v4u*)(t.WT + (size_t)(t.drow + n) * t.ldt + t.k0 + 8 * c) = o; }
    LDS_WAIT(); asm volatile("" ::: "memory");
}
__device__ __forceinline__ void rms_row_to_bf16(const float* xrow, const float* w, bf16* orow, int lane) {
    const f32x4* xr = (const f32x4*)xrow + lane; const f32x4* wr = (const f32x4*)w + lane;
    f32x4 v[8]; float s = 0.f;
#pragma unroll
    for (int j = 0; j < 8; ++j) { v[j] = xr[64 * j]; s += (v[j].x * v[j].x + v[j].y * v[j].y) + (v[j].z * v[j].z + v[j].w * v[j].w); }
    const float rstd = rsqrtf(wave_sum(s) * (1.f / DM) + RMS_EPS);
    v2u* o8 = (v2u*)orow + lane;
#pragma unroll
    for (int j = 0; j < 8; ++j) { const f32x4 g = wr[64 * j]; v2u o; o.x = pk2(v[j].x * rstd * g.x, v[j].y * rstd * g.y); o.y = pk2(v[j].z * rstd * g.z, v[j].w * rstd * g.w); o8[64 * j] = o; }
}
__device__ __forceinline__ void rms_row_sum2_to_f32(const bf16* hrow, const bf16* frow, const float* w, float* orow, int lane) {
    const v4u* hr = (const v4u*)hrow + lane; const v4u* fr_ = (const v4u*)frow + lane; const f32x4* wr = (const f32x4*)w;
    float v[4][8]; float s = 0.f;
#pragma unroll
    for (int j = 0; j < 4; ++j) { const v4u q = hr[64 * j], f = fr_[64 * j];
        v[j][0] = bf_lo(q.x) + bf_lo(f.x); v[j][1] = bf_hi(q.x) + bf_hi(f.x); v[j][2] = bf_lo(q.y) + bf_lo(f.y); v[j][3] = bf_hi(q.y) + bf_hi(f.y);
        v[j][4] = bf_lo(q.z) + bf_lo(f.z); v[j][5] = bf_hi(q.z) + bf_hi(f.z); v[j][6] = bf_lo(q.w) + bf_lo(f.w); v[j][7] = bf_hi(q.w) + bf_hi(f.w);
#pragma unroll
        for (int e = 0; e < 8; ++e) s += v[j][e] * v[j][e]; }
    const float rstd = rsqrtf(wave_sum(s) * (1.f / DM) + RMS_EPS);
    f32x4* o4 = (f32x4*)orow;
#pragma unroll
    for (int j = 0; j < 4; ++j) { const int i4 = 2 * (lane + 64 * j); const f32x4 g0 = wr[i4], g1 = wr[i4 + 1];
        o4[i4] = (f32x4){v[j][0] * rstd * g0[0], v[j][1] * rstd * g0[1], v[j][2] * rstd * g0[2], v[j][3] * rstd * g0[3]};
        o4[i4 + 1] = (f32x4){v[j][4] * rstd * g1[0], v[j][5] * rstd * g1[1], v[j][6] * rstd * g1[2], v[j][7] * rstd * g1[3]}; }
}
struct Ptrs {
    const float *xp, *xs, *norm_mix_w, *w_in, *rpb, *conv_w, *A_log, *dt_bias, *dn_norm_w, *w_out, *norm_ffn_w, *w_gate, *w_up, *w_down, *final_norm_w;
    float* out; unsigned char* ws;
};

constexpr int I_1 = (DM / 64) * (NIN / 32), I_O = (DM / 64) * (DM / 32), I_G = (DM / 64) * (DFF / 32), I_D = (DFF / 64) * (DM / 32);
constexpr int IT_W1 = 0, IT_WO = I_1, IT_G = I_1 + I_O, IT_D = I_1 + I_O + 2 * I_G, IT_END = IT_D + I_D;
__device__ __forceinline__ TrItem tr_decode(const Ptrs& P, int r) {
    TrItem t;
    if (r < I_1) { const int nb = r % (NIN / 32), kb = r / (NIN / 32); t.W = P.w_in; t.ks = nullptr; t.ldw = NIN; t.k0 = 64 * kb; t.n0 = 32 * nb; t.WT = (bf16*)(P.ws + WS_W1); t.ldt = DM; t.drow = 32 * nb; return t; } r -= I_1;
    if (r < I_O) { const int nb = r % (DM / 32), kb = r / (DM / 32); t.W = P.w_out; t.ks = nullptr; t.ldw = DM; t.k0 = 64 * kb; t.n0 = 32 * nb; t.WT = (bf16*)(P.ws + WS_WO); t.ldt = DM; t.drow = 32 * nb; return t; } r -= I_O;
    if (r < 2 * I_G) { const int up = r >= I_G; if (up) r -= I_G; const int nb = r % (DFF / 32), kb = r / (DFF / 32); const int n0 = 32 * nb;
        t.W = up ? P.w_up : P.w_gate; t.ks = P.norm_ffn_w; t.ldw = DFF; t.k0 = 64 * kb; t.n0 = n0; t.WT = (bf16*)(P.ws + WS_W3); t.ldt = DM; t.drow = 256 * (n0 >> 7) + (n0 & 127) + (up ? 128 : 0); return t; } r -= 2 * I_G;
    { const int nb = r % (DM / 32), kb = r / (DM / 32); t.W = P.w_down; t.ks = nullptr; t.ldw = DM; t.k0 = 64 * kb; t.n0 = 32 * nb; t.WT = (bf16*)(P.ws + WS_W4); t.ldt = DFF; t.drow = 32 * nb; return t; }
}
__device__ __forceinline__ void wconv_items(const Ptrs& P, LAS unsigned char* lds, int first, int last, int gwi, int ngwi, int wave, int lane) {
    LAS float* scr = (LAS float*)(lds + RING_OFF + wave * 16384);
    int it = first + gwi; if (it >= last) return;
#define WC_CL(i) ((i) < last ? (i) : it)
    TrItem a0 = tr_decode(P, it), b0 = tr_decode(P, WC_CL(it + ngwi)), a1, b1;
    f32x4 va0[8], vb0[8], va1[8], vb1[8], ka0[2], kb0[2], ka1[2], kb1[2];
    tr_load(a0, lane, va0, ka0); tr_load(b0, lane, vb0, kb0);
    for (;;) {
        const int i1 = it + 2 * ngwi; const bool m1 = i1 < last;
        a1 = tr_decode(P, m1 ? i1 : it); b1 = tr_decode(P, (m1 && i1 + ngwi < last) ? i1 + ngwi : (m1 ? i1 : it));
        tr_load(a1, lane, va1, ka1); tr_load(b1, lane, vb1, kb1);
        tr_store(a0, lane, va0, ka0, scr); tr_store(b0, lane, vb0, kb0, scr);
        if (!m1) break;
        const int i2 = i1 + 2 * ngwi; const bool m2 = i2 < last;
        a0 = tr_decode(P, m2 ? i2 : i1); b0 = tr_decode(P, (m2 && i2 + ngwi < last) ? i2 + ngwi : (m2 ? i2 : i1));
        tr_load(a0, lane, va0, ka0); tr_load(b0, lane, vb0, kb0);
        tr_store(a1, lane, va1, ka1, scr); tr_store(b1, lane, vb1, kb1, scr);
        if (!m2) break;
        it = i2;
    }
#undef WC_CL
}
__device__ __forceinline__ void p0_prologue(const Ptrs& P, LAS unsigned char* lds, int gw, int NGW, int wave, int lane) {
    wconv_items(P, lds, IT_W1, IT_WO, gw, NGW, wave, lane);
    bf16* W1t = (bf16*)(P.ws + WS_W1);
    { const v4u z = {0u, 0u, 0u, 0u}; v4u* zp = (v4u*)(W1t + (size_t)NIN * DM);
      for (int i = gw * 64 + lane; i < (NPROJ - NIN) * DM / 8; i += NGW * 64) zp[i] = z; }
    bf16* XN = (bf16*)(P.ws + WS_XN);
    for (int m = gw; m < M; m += NGW) { const float* xr = (m < MP) ? P.xp + (size_t)m * DM : P.xs + (size_t)(m - MP) * DM; rms_row_to_bf16(xr, P.norm_mix_w, XN + (size_t)m * DM, lane); }
}

#define WG_BAR_LDS() do { asm volatile("s_waitcnt lgkmcnt(0)" ::: "memory"); __builtin_amdgcn_s_barrier(); asm volatile("" ::: "memory"); } while (0)
typedef short s16x4 __attribute__((ext_vector_type(4)));
typedef short bf16x8v __attribute__((ext_vector_type(8)));
constexpr int NA_VST = 288, NA_VBUF = 32 * NA_VST;
constexpr float NA_LAZY = 8.0f;
constexpr int NA_KST = 272, NA_KIMG = 32 * NA_KST, NA_VIMG = 32 * NA_VST, NA_BUF = NA_KIMG + NA_VIMG, NA_BT = 4 * NA_BUF;
struct NaGeo { int qb, h, b, rg; };
__device__ __forceinline__ NaGeo na_geo(int task, int G) {
    const int blk = task % G, rnd = task / G, mem = (blk >> 3) & 15, bh = rnd * 16 + (blk & 7) * 2 + (blk >> 7), ty = mem >> 2;
    NaGeo g; g.qb = mem & 3; g.h = bh & 7; g.b = bh >> 3; g.rg = rnd == 4 ? (0xB4 >> (2 * ty)) & 3 : rnd == 5 ? (0x2D >> (2 * ty)) & 3 : (ty + rnd) & 3; return g;
}
__device__ __forceinline__ void na_mfma(const Ptrs& P, LAS unsigned char* lds, int wave, int lane_) {
    const bf16* Q = (const bf16*)(P.ws + WS_PROJ); const bf16* K = (const bf16*)(P.ws + WS_PROJ + PROJ_STRIDE); const bf16* V = (const bf16*)(P.ws + WS_PROJ + 2 * PROJ_STRIDE);
    bf16* Y = (bf16*)(P.ws + WS_XN);
    LAS float* BT = (LAS float*)(lds + NA_BT);
    int bt_head = -1;
    const int G_ = (int)gridDim.x, NTASK = NSEQ * NH * 4 * 4;
    bf16x8v nQf[4]; v4u nsk0, nsv0, nsk1, nsv1;
#define NA_NEXT(ge_) do { int ln_ = lane_; asm volatile("" : "+v"(ln_)); const int t_ = wave * 64 + ln_; const NaGeo e_ = (ge_); \
        const size_t tq_ = (size_t)e_.b * SEQ + (8 * e_.rg + wave) * 64 + 16 * e_.qb + (ln_ & 15); \
        _Pragma("unroll") for (int ks = 0; ks < 4; ++ks) nQf[ks] = *(const bf16x8v*)(Q + tq_ * 1024 + e_.h * HD + 32 * ks + 8 * (ln_ >> 4)); \
        const int kl_ = min(max(8 * e_.rg - 4, 0), 24); \
        const size_t sb_ = ((size_t)e_.b * SEQ + min(max(16 * e_.qb - 8, 0), 32) + (t_ >> 4)) * 1024 + e_.h * HD + 8 * (t_ & 15) + (size_t)kl_ * 64 * 1024; \
        nsk0 = *(const v4u*)(K + sb_); nsv0 = *(const v4u*)(V + sb_); nsk1 = *(const v4u*)(K + sb_ + 64 * 1024); nsv1 = *(const v4u*)(V + sb_ + 64 * 1024); } while (0)
    NaGeo gnext = na_geo((int)blockIdx.x, G_);
    NA_NEXT(gnext);
    for (int task = blockIdx.x; task < NTASK; task += G_) {
        int lane = lane_; asm volatile("" : "+v"(lane));
        const int fr = lane & 15, g = lane >> 4, tid = wave * 64 + lane;
        const NaGeo ge = gnext;
        const int qb = ge.qb, h = ge.h, b = ge.b, rg = ge.rg;
        const bool has_next = task + G_ < NTASK;
        if (has_next) gnext = na_geo(task + G_, G_);
        const int r = 8 * rg + wave, rs = min(max(r - 4, 0), 24), kb0 = min(max(16 * qb - 8, 0), 32);
        const int kr_lo = min(max(8 * rg - 4, 0), 24), kr_hi = min(max(8 * rg + 3, 0), 24) + 7;
        const int c = 16 * qb + fr, cs = min(max(c - 8, 0), 48);
        const size_t tq = (size_t)b * SEQ + r * 64 + c;
        const int skey = tid >> 4, spart = tid & 15;
        const size_t sbase = ((size_t)b * SEQ + kb0 + skey) * 1024 + h * HD + 8 * spart;
        const int kofs = skey * NA_KST + spart * 16, vofs = NA_KIMG + skey * NA_VST + spart * 16;
#define NA_LD(kr_, sk_, sv_) do { const size_t o_ = sbase + (size_t)min((kr_), kr_hi) * 64 * 1024; sk_ = *(const v4u*)(K + o_); sv_ = *(const v4u*)(V + o_); } while (0)
        v4u skPa, svPa, skPb, svPb, skQa, svQa, skQb, svQb;
        NA_LD(kr_lo + 2, skPa, svPa); NA_LD(kr_lo + 3, skPb, svPb); NA_LD(kr_lo + 4, skQa, svQa); NA_LD(kr_lo + 5, skQb, svQb);
        bf16x8v Qf[4];
#pragma unroll
        for (int ks = 0; ks < 4; ++ks) Qf[ks] = nQf[ks];
        const v4u sk0 = nsk0, sv0 = nsv0, sk1 = nsk1, sv1 = nsv1;
        const bool bt_new = (h != bt_head); float bias_in = 0.f;
        if (bt_new && tid < 465) bias_in = P.rpb[h * 465 + tid];
        WG_BAR_LDS();
        *(LAS v4u*)(lds + kofs) = sk0; *(LAS v4u*)(lds + vofs) = sv0; *(LAS v4u*)(lds + NA_BUF + kofs) = sk1; *(LAS v4u*)(lds + NA_BUF + vofs) = sv1;
        if (bt_new && tid < 465) BT[tid] = bias_in;
        bt_head = h;
        f32x4 O[8];
#pragma unroll
        for (int dt = 0; dt < 8; ++dt) O[dt] = (f32x4){0.f, 0.f, 0.f, 0.f};
        float mrun = -INFINITY, lrun = 0.f;
        int bi[8]; bool bv[8];
#pragma unroll
        for (int e = 0; e < 4; ++e) { const int kc0 = kb0 + 4 * g + e, kc1 = kc0 + 16; bv[e] = (kc0 >= cs) && (kc0 < cs + 16); bv[4 + e] = (kc1 >= cs) && (kc1 < cs + 16);
            bi[e] = min(max(kc0 - c + 15, 0), 30); bi[4 + e] = min(max(kc1 - c + 15, 0), 30); }
        WG_BAR_LDS();
#define NA_ROW(kr_) do { const int kr = (kr_); \
            if (kr >= rs && kr < rs + 8) { LAS unsigned char* buf = lds + ((kr - kr_lo) & 3) * NA_BUF; \
                  \
                const unsigned vtr = (unsigned)(size_t)(buf + NA_KIMG) + (unsigned)((4 * g + ((lane & 15) >> 2)) * NA_VST + (lane & 3) * 8); \
                s16x4 lo[8], hi[8]; \
                _Pragma("unroll") for (int d = 0; d < 8; ++d) { \
                    asm volatile("ds_read_b64_tr_b16 %0, %1 offset:%c2" : "=&v"(lo[d]) : "v"(vtr), "i"(d * 32) : "memory"); \
                    asm volatile("ds_read_b64_tr_b16 %0, %1 offset:%c2" : "=&v"(hi[d]) : "v"(vtr), "i"(d * 32 + 16 * NA_VST) : "memory"); } \
                  \
                const unsigned kpa = (unsigned)(size_t)(buf + fr * NA_KST + 16 * g), bra = (unsigned)(size_t)(BT + (kr - r + 7) * 31); \
                bf16x8v kf[8]; float bb[8]; \
                _Pragma("unroll") for (int ks = 0; ks < 4; ++ks) { \
                    asm volatile("ds_read_b128 %0, %1 offset:%c2" : "=&v"(kf[2 * ks]) : "v"(kpa), "i"(64 * ks) : "memory"); \
                    asm volatile("ds_read_b128 %0, %1 offset:%c2" : "=&v"(kf[2 * ks + 1]) : "v"(kpa), "i"(16 * NA_KST + 64 * ks) : "memory"); } \
                _Pragma("unroll") for (int e = 0; e < 8; ++e) asm volatile("ds_read_b32 %0, %1" : "=&v"(bb[e]) : "v"(bra + 4u * (unsigned)bi[e]) : "memory"); \
                asm volatile("s_waitcnt lgkmcnt(0)" ::: "memory"); __builtin_amdgcn_sched_barrier(0); \
                f32x4 s0 = {0.f, 0.f, 0.f, 0.f}, s1 = {0.f, 0.f, 0.f, 0.f}; \
                _Pragma("unroll") for (int ks = 0; ks < 4; ++ks) { s0 = __builtin_amdgcn_mfma_f32_16x16x32_bf16(kf[2 * ks], Qf[ks], s0, 0, 0, 0); \
                    s1 = __builtin_amdgcn_mfma_f32_16x16x32_bf16(kf[2 * ks + 1], Qf[ks], s1, 0, 0, 0); } \
                float mx = -INFINITY; \
                _Pragma("unroll") for (int e = 0; e < 4; ++e) { s0[e] = bv[e] ? s0[e] * QSCALE + bb[e] : -INFINITY; s1[e] = bv[4 + e] ? s1[e] * QSCALE + bb[4 + e] : -INFINITY; mx = fmaxf(mx, fmaxf(s0[e], s1[e])); } \
                if (__builtin_amdgcn_ballot_w64(mx > mrun + NA_LAZY) != 0ull) {          \
                    mx = fmaxf(mx, __shfl_xor(mx, 16)); mx = fmaxf(mx, __shfl_xor(mx, 32)); \
                    const float mnew = fmaxf(mrun, mx), alpha = __expf(mrun - mnew); \
                    lrun *= alpha; mrun = mnew; \
                    _Pragma("unroll") for (int dt = 0; dt < 8; ++dt) O[dt] = O[dt] * alpha; } \
                _Pragma("unroll") for (int e = 0; e < 4; ++e) { s0[e] = __expf(s0[e] - mrun); s1[e] = __expf(s1[e] - mrun); lrun += s0[e] + s1[e]; } \
                v4u pw; pw.x = pk2(s0[0], s0[1]); pw.y = pk2(s0[2], s0[3]); pw.z = pk2(s1[0], s1[1]); pw.w = pk2(s1[2], s1[3]); \
                const bf16x8v Pf = __builtin_bit_cast(bf16x8v, pw); \
                _Pragma("unroll") for (int d = 0; d < 8; ++d) { const bf16x8v Vf = (bf16x8v){lo[d][0], lo[d][1], lo[d][2], lo[d][3], hi[d][0], hi[d][1], hi[d][2], hi[d][3]}; \
                    O[d] = __builtin_amdgcn_mfma_f32_16x16x32_bf16(Vf, Pf, O[d], 0, 0, 0); } \
            } } while (0)
#define NA_DSTEP(k0_, skWa, svWa, skWb, svWb) do { const int k0 = (k0_); \
            if (has_next && k0 <= kr_hi && k0 + 2 > kr_hi) NA_NEXT(gnext);          \
            NA_ROW(k0); NA_ROW(k0 + 1); \
            if (k0 + 2 <= kr_hi) { LAS unsigned char* nb = lds + ((k0 + 2 - kr_lo) & 3) * NA_BUF; *(LAS v4u*)(nb + kofs) = skWa; *(LAS v4u*)(nb + vofs) = svWa; } \
            if (k0 + 3 <= kr_hi) { LAS unsigned char* nb = lds + ((k0 + 3 - kr_lo) & 3) * NA_BUF; *(LAS v4u*)(nb + kofs) = skWb; *(LAS v4u*)(nb + vofs) = svWb; } \
            NA_LD(k0 + 6, skWa, svWa); NA_LD(k0 + 7, skWb, svWb);               \
            WG_BAR_LDS(); } while (0)
#pragma unroll 1
        for (int k4 = kr_lo; k4 <= kr_hi; k4 += 4) {
            NA_DSTEP(k4, skPa, svPa, skPb, svPb); NA_DSTEP(k4 + 2, skQa, svQa, skQb, svQb);
        }
#undef NA_DSTEP
#undef NA_ROW
#undef NA_LD
        lrun += __shfl_xor(lrun, 16); lrun += __shfl_xor(lrun, 32);
        const float inv = 1.0f / lrun;
        bf16* yp = Y + tq * DM + h * HD + 4 * g;
#pragma unroll
        for (int dt = 0; dt < 8; ++dt) { v2u o; o.x = pk2(O[dt][0] * inv, O[dt][1] * inv); o.y = pk2(O[dt][2] * inv, O[dt][3] * inv); *(v2u*)(yp + 16 * dt) = o; }
    }
#undef NA_NEXT
}
typedef float f32x16 __attribute__((ext_vector_type(16)));
constexpr int IST = 272;
constexpr int L_QI = 0, L_KI = 17408, L_VI = 34816, TST = 136, TIMG = 64 * TST;
constexpr size_t WS_EG = 544 * MiB;
constexpr size_t PRE_QF = WS_PRE, PRE_KTF = WS_PRE + 48 * MiB, PRE_QKF = WS_PRE + 96 * MiB;
constexpr size_t OUT_WF = 0, OUT_UF = 96 * MiB;
constexpr int NUNIT = NSEQ * NH * 32;
__device__ __forceinline__ int rowof(int reg, int hh) { return (reg & 3) + 8 * (reg >> 2) + 4 * hh; }
__device__ __forceinline__ f32x16 mfma32(bf16x8v a, bf16x8v b, f32x16 c) { return __builtin_amdgcn_mfma_f32_32x32x16_bf16(a, b, c, 0, 0, 0); }
__device__ __forceinline__ bf16x8v pack8(const float* v) { v4u w; w.x = pk2(v[0], v[1]); w.y = pk2(v[2], v[3]); w.z = pk2(v[4], v[5]); w.w = pk2(v[6], v[7]); return __builtin_bit_cast(bf16x8v, w); }
__device__ __forceinline__ void split8(const float* v, bf16x8v& hi, bf16x8v& lo) {
    float r[8]; v4u w; w.x = pk2(v[0], v[1]); w.y = pk2(v[2], v[3]); w.z = pk2(v[4], v[5]); w.w = pk2(v[6], v[7]); hi = __builtin_bit_cast(bf16x8v, w);
    r[0] = v[0] - bf_lo(w.x); r[1] = v[1] - bf_hi(w.x); r[2] = v[2] - bf_lo(w.y); r[3] = v[3] - bf_hi(w.y); r[4] = v[4] - bf_lo(w.z); r[5] = v[5] - bf_hi(w.z); r[6] = v[6] - bf_lo(w.w); r[7] = v[7] - bf_hi(w.w);
    lo = pack8(r);
}
__device__ __forceinline__ bf16x8v pi_frag(const LAS unsigned char* img, int stride, int row0, int col0, int lane) {
    const LAS unsigned char* p = img + (row0 + (lane & 31)) * stride + (col0 + 4 * (lane >> 5)) * 2;
    const v2u a = *(const LAS v2u*)p, b = *(const LAS v2u*)(p + 16); v4u w; w.x = a.x; w.y = a.y; w.z = b.x; w.w = b.y; return __builtin_bit_cast(bf16x8v, w);
}
__device__ __forceinline__ bf16x8v tr_frag(unsigned img_addr, int stride, int krow0, int col0, int lane) {
    const unsigned a = img_addr + (unsigned)((krow0 + 4 * (lane >> 5) + ((lane & 15) >> 2)) * stride + (col0 + 16 * ((lane >> 4) & 1) + 4 * (lane & 3)) * 2);
    s16x4 lo, hi;
    asm volatile("ds_read_b64_tr_b16 %0, %1" : "=&v"(lo) : "v"(a) : "memory");
    asm volatile("ds_read_b64_tr_b16 %0, %1" : "=&v"(hi) : "v"(a + (unsigned)(8 * stride)) : "memory");
    asm volatile("s_waitcnt lgkmcnt(0)" ::: "memory"); __builtin_amdgcn_sched_barrier(0);
    return (bf16x8v){lo[0], lo[1], lo[2], lo[3], hi[0], hi[1], hi[2], hi[3]};
}
constexpr int P2_SET = 52224, P2_AM = 2 * P2_SET, P2_XT = P2_AM + 16384, P2_VEC = P2_XT + 17408, P2_CW = P2_VEC + 4096;
static_assert(P2_CW + 7680 <= LDSCTL_OFF, "pipelined pre-phase LDS map");
template <bool REV> __device__ __forceinline__ void dn_solve_a(const LAS float* AM, LAS float* XT, float (&x)[32], f32x16& Th, int lane) {
    const int blk = lane >> 5, c = lane & 31, hh = lane >> 5;
#pragma unroll
    for (int i = 0; i < 32; ++i) {
        float acc = (i == c) ? 1.f : 0.f;
        int rofs = (REV ? 63 - 32 * blk - i : 32 * blk + i) * 64;
        if (i >= 3) asm volatile("" : "+v"(rofs) : "v"(x[i - 3]));
        const LAS float* rp = AM + rofs;
#pragma unroll
        for (int qd = 0; qd < (i + 3) / 4; ++qd) {
            const f32x4 a = REV ? *(const LAS f32x4*)(rp + 60 - 32 * blk - 4 * qd) : *(const LAS f32x4*)(rp + 32 * blk + 4 * qd);
#pragma unroll
            for (int e = 0; e < 4; ++e) if (4 * qd + e < i) acc -= (REV ? a[3 - e] : a[e]) * x[4 * qd + e];
        }
        x[i] = acc;
    }
#pragma unroll
    for (int qd = 0; qd < 8; ++qd) *(LAS f32x4*)(XT + lane * 32 + 4 * qd) = (f32x4){x[4 * qd], x[4 * qd + 1], x[4 * qd + 2], x[4 * qd + 3]};
    LDS_WAIT();
    f32x16 Pm;
#pragma unroll
    for (int r = 0; r < 16; ++r) Pm[r] = 0.f;
#pragma unroll
    for (int s = 0; s < 2; ++s) {
        float av[8], bv[8];
        const LAS float* rp = AM + (REV ? 31 - c : 32 + c) * 64;
        if (REV) { const f32x4 alo = *(const LAS f32x4*)(rp + 56 - 16 * s - 8 * hh), ahi = *(const LAS f32x4*)(rp + 60 - 16 * s - 8 * hh);
            av[0] = ahi[3]; av[1] = ahi[2]; av[2] = ahi[1]; av[3] = ahi[0]; av[4] = alo[3]; av[5] = alo[2]; av[6] = alo[1]; av[7] = alo[0]; }
        else { const f32x4 a0 = *(const LAS f32x4*)(rp + 16 * s + 8 * hh), a1 = *(const LAS f32x4*)(rp + 16 * s + 8 * hh + 4);
            av[0] = a0[0]; av[1] = a0[1]; av[2] = a0[2]; av[3] = a0[3]; av[4] = a1[0]; av[5] = a1[1]; av[6] = a1[2]; av[7] = a1[3]; }
        { const f32x4 b0 = *(const LAS f32x4*)(XT + c * 32 + 16 * s + 8 * hh), b1 = *(const LAS f32x4*)(XT + c * 32 + 16 * s + 8 * hh + 4);
            bv[0] = b0[0]; bv[1] = b0[1]; bv[2] = b0[2]; bv[3] = b0[3]; bv[4] = b1[0]; bv[5] = b1[1]; bv[6] = b1[2]; bv[7] = b1[3]; }
        bf16x8v ah, al, bh, bl; split8(av, ah, al); split8(bv, bh, bl);
        Pm = mfma32(ah, bh, Pm); Pm = mfma32(ah, bl, Pm); Pm = mfma32(al, bh, Pm);
    }
#pragma unroll
    for (int r = 0; r < 16; ++r) Th[r] = 0.f;
#pragma unroll
    for (int s = 0; s < 2; ++s) {
        float av[8], pv[8];
#pragma unroll
        for (int j = 0; j < 8; ++j) { const int k = 16 * s + 8 * (j >> 2) + 4 * hh + (j & 3); av[j] = XT[(32 + k) * 32 + c]; pv[j] = Pm[8 * s + j]; }
        bf16x8v ah, al, ph, pl; split8(av, ah, al); split8(pv, ph, pl);
        Th = mfma32(ah, ph, Th); Th = mfma32(ah, pl, Th); Th = mfma32(al, ph, Th);
    }
    LDS_WAIT();
}
template <bool REV> __device__ __forceinline__ void dn_solve_b(const float (&x)[32], const f32x16& Th, const LAS float* BETA, const LAS float* BG, const LAS float* NK, LAS unsigned char* TB, int lane) {
    LAS unsigned char* TBG = TB + TIMG;
    { const v4u z = {0u, 0u, 0u, 0u};
#pragma unroll
      for (int i = 0; i < 17; ++i) *(LAS v4u*)(TB + (lane + 64 * i) * 16) = z; }
    LDS_WAIT();
    const int blk = lane >> 5, c = lane & 31, hh = lane >> 5;
    { const int colo = REV ? 63 - (32 * blk + c) : 32 * blk + c; const float sb = BETA[colo], sg = BG[colo] * NK[colo];
#pragma unroll
        for (int i = 0; i < 32; ++i) { const int rowo = REV ? 63 - (32 * blk + i) : 32 * blk + i;
            *(LAS unsigned short*)(TB + rowo * TST + colo * 2) = (unsigned short)(pk2(x[i] * sb, 0.f) & 0xffffu); *(LAS unsigned short*)(TBG + rowo * TST + colo * 2) = (unsigned short)(pk2(x[i] * sg, 0.f) & 0xffffu); } }
    { const int colo = REV ? 63 - c : c; const float sb = BETA[colo], sg = BG[colo] * NK[colo];
#pragma unroll
        for (int r = 0; r < 16; ++r) { const int i = 32 + rowof(r, hh); const int rowo = REV ? 63 - i : i; const float v = -Th[r];
            *(LAS unsigned short*)(TB + rowo * TST + colo * 2) = (unsigned short)(pk2(v * sb, 0.f) & 0xffffu); *(LAS unsigned short*)(TBG + rowo * TST + colo * 2) = (unsigned short)(pk2(v * sg, 0.f) & 0xffffu); } }
}
__device__ __forceinline__ void dn_pre2(const Ptrs& P, LAS unsigned char* lds, int tid_, int wave, int lane_) {
    const bf16* DNX = (const bf16*)(P.ws + WS_PROJ + 3 * PROJ_STRIDE); const float* BA = (const float*)(P.ws + WS_BA);
    unsigned char* outb = (unsigned char*)P.out;
    const unsigned ldsa = (unsigned)(size_t)lds;
    LAS float* CW = (LAS float*)(lds + P2_CW);
    const int G = gridDim.x; const int u0 = blockIdx.x;
    if (u0 >= NUNIT) return;
    const int hfix = (u0 >> 5) & 7;
    float c_aexp = 0.f, c_dtb = 0.f;
    unsigned xr[3][20]; float ba_b = 0.f, ba_a = 0.f;
#define P2_REQ(un_) do { const int chunk2 = (un_) & 31, h2 = ((un_) >> 5) & 7, b2 = (un_) >> 8; const int t02 = chunk2 * 64; \
        if (wave >= 2 && wave < 6) { _Pragma("unroll") for (int x = 0; x < 3; ++x) { const bf16* X = DNX + (size_t)x * (PROJ_STRIDE / 2) + h2 * HD + 2 * lane; \
            _Pragma("unroll") for (int i = 0; i < 20; ++i) { const int t = t02 + 16 * (wave - 2) - 2 + i; xr[x][i] = (t >= 0 && t < SEQ) ? *(const unsigned*)(X + ((size_t)b2 * SEQ + t) * 1024) : 0u; } } } \
        if (wave >= 6) { const size_t m2 = (size_t)b2 * SEQ + t02 + lane; ba_b = BA[m2 * 32 + (wave - 6) * 8 + h2]; ba_a = BA[m2 * 32 + 16 + (wave - 6) * 8 + h2]; } } while (0)
#define P2_S1T(un_, set_, T0_, T1_, GATES_, REQ_) do { \
        if (wave >= 2 && wave < 6) { \
            _Pragma("unroll") for (int x = 0; x < 3; ++x) { f32x2 cw[5]; \
                _Pragma("unroll") for (int j = 0; j < 5; ++j) cw[j] = *(const LAS f32x2*)(CW + (x * 5 + j) * 128 + 2 * lane); \
                f32x2 xf[20]; _Pragma("unroll") for (int i = (T0_); i < (T1_) + 4; ++i) xf[i] = (f32x2){bf_lo(xr[x][i]), bf_hi(xr[x][i])}; \
                _Pragma("unroll") for (int tt = (T0_); tt < (T1_); ++tt) { f32x2 yy = cw[0] * xf[tt]; \
                    _Pragma("unroll") for (int j = 1; j < 5; ++j) yy = __builtin_elementwise_fma(cw[j], xf[tt + j], yy); \
                    float y0 = yy.x, y1 = yy.y; \
                    y0 = y0 * __builtin_amdgcn_rcpf(1.0f + __expf(-y0)); y1 = y1 * __builtin_amdgcn_rcpf(1.0f + __expf(-y1)); \
                    *(LAS unsigned*)(lds + (set_) * P2_SET + x * 17408 + (16 * (wave - 2) + tt) * IST + 4 * lane) = pk2(y0, y1); } } } \
        if ((GATES_) && wave >= 6) { const int d = wave - 6; LAS float* VEC = (LAS float*)(lds + P2_VEC + (set_) * 2048); \
            const float beta = sigmoid_f(ba_b); float Gs = -c_aexp * softplus_f(ba_a + c_dtb); \
            if (d == 0) { _Pragma("unroll") for (int o = 1; o < 64; o <<= 1) { const float t = __shfl_up(Gs, o); if (lane >= o) Gs += t; } } \
            else { _Pragma("unroll") for (int o = 1; o < 64; o <<= 1) { const float t = __shfl_down(Gs, o); if (lane + o < 64) Gs += t; } } \
            const float eG = expf(Gs); \
            VEC[d * 64 + lane] = beta; VEC[128 + d * 64 + lane] = beta * eG; VEC[256 + d * 64 + lane] = Gs; } \
        if ((REQ_) && (un_) + G < NUNIT) P2_REQ((un_) + G); } while (0)
#define P2_S1(un_, set_) P2_S1T(un_, set_, 0, 16, 1, 1)
    constexpr int P2_TS = 16;
    int lane = lane_, tid = tid_;
    for (int i = tid; i < 3 * 5 * 128; i += 512) { const int x = i / 640, j = (i / 128) % 5, ch = i & 127; CW[i] = P.conv_w[(size_t)j * 3072 + x * 1024 + hfix * HD + ch]; }
    if (wave >= 6) { c_aexp = expf(P.A_log[(wave - 6) * 8 + hfix]); c_dtb = P.dt_bias[(wave - 6) * 8 + hfix]; }
    P2_REQ(u0);
    WG_BAR_LDS();
    P2_S1(u0, 0);
    int it = 0;
    for (int u = u0; u < NUNIT; u += G, ++it) {
        lane = lane_; tid = tid_; asm volatile("" : "+v"(lane), "+v"(tid));
        const int r31 = lane & 31, hh = lane >> 5; const int set = it & 1;
        LAS unsigned char* IMG = lds + set * P2_SET; const unsigned imga = ldsa + set * P2_SET;
        LAS float* VEC = (LAS float*)(lds + P2_VEC + set * 2048);
        LAS float* AM = (LAS float*)(lds + P2_AM);
        WG_BAR_LDS();
        { const int ta = (wave >> 1) & 1, tb = wave & 1;
            const LAS unsigned char* ab = IMG + L_KI + (32 * ta + r31) * IST + 16 * hh; const LAS unsigned char* bb = IMG + (wave < 4 ? L_KI : L_QI) + (32 * tb + r31) * IST + 16 * hh;
            f32x16 acc;
#pragma unroll
            for (int r = 0; r < 16; ++r) acc[r] = 0.f;
#pragma unroll
            for (int s8 = 0; s8 < 8; ++s8) acc = mfma32(*(const LAS bf16x8v*)(ab + 32 * s8), *(const LAS bf16x8v*)(bb + 32 * s8), acc);
            if (wave == 0 || wave == 3 || wave == 4 || wave == 5) {
                f32x16 dq = acc;
                if (wave >= 4) { const LAS unsigned char* qb_ = IMG + L_QI + (32 * (wave - 4) + r31) * IST + 16 * hh;
#pragma unroll
                    for (int r = 0; r < 16; ++r) dq[r] = 0.f;
#pragma unroll
                    for (int s8 = 0; s8 < 8; ++s8) dq = mfma32(*(const LAS bf16x8v*)(qb_ + 32 * s8), *(const LAS bf16x8v*)(qb_ + 32 * s8), dq); }
                float dv = 0.f;
#pragma unroll
                for (int r = 0; r < 16; ++r) if (rowof(r, hh) == r31) dv = dq[r];
                const int trow = (wave >= 4) ? 32 * (wave - 4) : 32 * ta;
                if (((r31 >> 2) & 1) == hh) { const float rn = rsqrtf(dv + L2_EPS); if (wave >= 4) VEC[384 + trow + r31] = rn * QSCALE; else VEC[448 + trow + r31] = rn; }
            }
            WG_BAR_LDS();
            if (wave < 4) {
                const int j = 32 * tb + r31; const float Gj0 = VEC[256 + j], Gj1 = VEC[256 + 64 + j], nkj = VEC[448 + j];
#pragma unroll
                for (int q4 = 0; q4 < 4; ++q4) { const int ib = 32 * ta + 8 * q4 + 4 * hh;
                    const f32x4 be0 = *(const LAS f32x4*)(VEC + ib), be1 = *(const LAS f32x4*)(VEC + 64 + ib), nk4 = *(const LAS f32x4*)(VEC + 448 + ib), g0 = *(const LAS f32x4*)(VEC + 256 + ib), g1 = *(const LAS f32x4*)(VEC + 320 + ib);
#pragma unroll
                    for (int e = 0; e < 4; ++e) { const int i = ib + e; const bool d = i < j;
                        const float v = (d ? be1[e] : be0[e]) * nk4[e] * nkj * acc[4 * q4 + e] * __expf(fminf((d ? g1[e] - Gj1 : g0[e] - Gj0), 0.f));
                        AM[i * 64 + j] = (i == j) ? 0.f : v; } }
                if (wave == 1 || wave == 2) { const int d = wave - 1; const float Gc = VEC[256 + d * 64 + lane], Gl = VEC[256 + d * 64 + (d ? 0 : 63)];
                    float* rec = (float*)(P.ws + WS_EG) + ((size_t)d * NUNIT + u) * 160;
                    rec[lane] = __expf(Gc) * VEC[384 + lane]; rec[64 + lane] = __expf(Gl - Gc) * VEC[448 + lane]; if (lane == 0) rec[128] = __expf(Gl); }
            } else {
                const int cc = 32 * tb + r31; const float nqc = VEC[384 + cc], Gc0 = VEC[256 + cc], Gc1 = VEC[320 + cc];
#pragma unroll
                for (int sf = 0; sf < 2; ++sf) { float v0[8], v1[8];
#pragma unroll
                    for (int jj = 0; jj < 2; ++jj) { const int cb = 32 * ta + 16 * sf + 8 * jj + 4 * hh;
                        const f32x4 nk4 = *(const LAS f32x4*)(VEC + 448 + cb), g0 = *(const LAS f32x4*)(VEC + 256 + cb), g1 = *(const LAS f32x4*)(VEC + 320 + cb);
#pragma unroll
                        for (int e = 0; e < 4; ++e) { const int cp = cb + e; const float a = acc[8 * sf + 4 * jj + e] * nqc * nk4[e];
                            v0[4 * jj + e] = (cp <= cc) ? a * __expf(fminf(Gc0 - g0[e], 0.f)) : 0.f;
                            v1[4 * jj + e] = (cp >= cc) ? a * __expf(fminf(Gc1 - g1[e], 0.f)) : 0.f; } }
                    *(bf16x8v*)(P.ws + PRE_QKF + ((size_t)u) * 8192 + (size_t)((tb * 4 + 2 * ta + sf) * 64 + lane) * 16) = pack8(v0);
                    *(bf16x8v*)(P.ws + PRE_QKF + ((size_t)NUNIT + u) * 8192 + (size_t)((tb * 4 + 2 * ta + sf) * 64 + lane) * 16) = pack8(v1); }
            }
        }
        WG_BAR_LDS();
        float x[32]; f32x16 Th;
        if (wave == 0) dn_solve_a<false>(AM, (LAS float*)(lds + P2_XT), x, Th, lane);
        else if (wave == 1) dn_solve_a<true>(AM, (LAS float*)(lds + P2_XT + 8192), x, Th, lane);
        else if (wave < 6) { if (u + G < NUNIT) P2_S1T(u + G, set ^ 1, 0, P2_TS, 0, 0); }
        else {
            if (u + G < NUNIT) P2_S1T(u + G, set ^ 1, 0, 0, 1, 1);
#pragma unroll
            for (int e = 0; e < 8; ++e) { const int idx = (wave - 6) * 8 + e; const int ct = idx >> 3, s8 = idx & 7; const bf16x8v f = pi_frag(IMG + L_QI, IST, 32 * ct, 16 * s8, lane);
                *(bf16x8v*)(P.ws + PRE_QF + (size_t)u * 16384 + (size_t)(idx * 64 + lane) * 16) = f; }
        }
        WG_BAR_LDS();
        if (wave == 0) dn_solve_b<false>(x, Th, VEC, VEC + 128, VEC + 448, IMG + L_QI, lane);
        else if (wave == 1) dn_solve_b<true>(x, Th, VEC + 64, VEC + 128 + 64, VEC + 448, lds + P2_XT, lane);
        else if (wave < 6) { if (u + G < NUNIT) P2_S1T(u + G, set ^ 1, P2_TS, 16, 0, 1); }
        WG_BAR_LDS();
        { const int kind = wave >> 2, xt = wave & 3;
            bf16x8v xf[4];
#pragma unroll
            for (int s4 = 0; s4 < 4; ++s4) xf[s4] = tr_frag(imga + (kind ? L_KI : L_VI), IST, 16 * s4, 32 * xt, lane);
            if (kind) {
#pragma unroll
                for (int s4 = 0; s4 < 4; ++s4) *(bf16x8v*)(P.ws + PRE_KTF + (size_t)u * 16384 + (size_t)((xt * 4 + s4) * 64 + lane) * 16) = xf[s4]; }
#pragma unroll 1
            for (int dc = 0; dc < 4; ++dc) { const int d = dc >> 1, ct = dc & 1;
                const LAS unsigned char* Ti = (d ? lds + P2_XT : IMG + L_QI) + kind * TIMG;
                f32x16 acc;
#pragma unroll
                for (int r = 0; r < 16; ++r) acc[r] = 0.f;
                if (kind == 0) {
#pragma unroll
                    for (int s4 = 0; s4 < 4; ++s4) acc = mfma32(pi_frag(Ti, TST, 32 * ct, 16 * s4, lane), xf[s4], acc);
                    float v[16];
#pragma unroll
                    for (int r = 0; r < 16; ++r) v[r] = acc[r];
                    bf16x8v* dst = (bf16x8v*)(outb + OUT_UF + ((size_t)d * NUNIT + u) * 16384 + (size_t)((ct * 4 + xt) * 64 + lane) * 32);
                    dst[0] = pack8(v); dst[1] = pack8(v + 8);
                } else {
#pragma unroll
                    for (int s4 = 0; s4 < 4; ++s4) acc = mfma32(xf[s4], pi_frag(Ti, TST, 32 * ct, 16 * s4, lane), acc);
                    float v[16];
#pragma unroll
                    for (int r = 0; r < 16; ++r) v[r] = -acc[r];
                    unsigned char* base = outb + OUT_WF + ((size_t)d * NUNIT + u) * 16384;
                    *(bf16x8v*)(base + (size_t)((ct * 8 + 2 * xt) * 64 + lane) * 16) = pack8(v);
                    *(bf16x8v*)(base + (size_t)((ct * 8 + 2 * xt + 1) * 64 + lane) * 16) = pack8(v + 8);
                }
            }
        }
    }
    WG_BAR_LDS();
#undef P2_REQ
#undef P2_S1
}
constexpr int SC_BUF = 58368, SC_WF = 0, SC_QF = 16384, SC_QKF = 32768, SC_KTF = 40960, SC_EG = 57344;
static_assert(2 * SC_BUF <= LDSCTL_OFF, "scan LDS map");
__device__ __forceinline__ void dn_scan2(const Ptrs& P, LAS unsigned char* lds, int wave, int lane_) {
    const unsigned char* outb = (const unsigned char*)P.out;
    for (int chain = blockIdx.x; chain < NSEQ * NH * 2; chain += gridDim.x) {
        const int d = chain & 1, h = (chain >> 1) & 7, b = chain >> 4;
        if (wave >= 4) {
            const int li = wave - 4;
#pragma unroll 1
            for (int step = -1; step < 32; ++step) {
                if (step + 1 < 32) {
                    int lane = lane_; asm volatile("" : "+v"(lane));
                    const int ci = d ? 31 - (step + 1) : (step + 1); const int u = (b * 8 + h) * 32 + ci; const size_t du = (size_t)d * NUNIT + u;
                    LAS unsigned char* buf = lds + ((step + 1) & 1) * SC_BUF;
                    const unsigned char* gWF = outb + OUT_WF + du * 16384 + lane * 16; const unsigned char* gQF = P.ws + PRE_QF + (size_t)u * 16384 + lane * 16;
                    const unsigned char* gQKF = P.ws + PRE_QKF + du * 8192 + lane * 16; const unsigned char* gKTF = P.ws + PRE_KTF + (size_t)u * 16384 + lane * 16;
#pragma unroll
                    for (int k = 0; k < 4; ++k) { const int j = li + 4 * k;
                        __builtin_amdgcn_global_load_lds((const unsigned*)(gWF + j * 1024), (LAS unsigned*)(buf + SC_WF + j * 1024), 16, 0, 0);
                        __builtin_amdgcn_global_load_lds((const unsigned*)(gQF + j * 1024), (LAS unsigned*)(buf + SC_QF + j * 1024), 16, 0, 0);
                        __builtin_amdgcn_global_load_lds((const unsigned*)(gKTF + j * 1024), (LAS unsigned*)(buf + SC_KTF + j * 1024), 16, 0, 0); }
#pragma unroll
                    for (int k = 0; k < 2; ++k) { const int j = li + 4 * k;
                        __builtin_amdgcn_global_load_lds((const unsigned*)(gQKF + j * 1024), (LAS unsigned*)(buf + SC_QKF + j * 1024), 16, 0, 0); }
                    if (li == 0) __builtin_amdgcn_global_load_lds((const unsigned*)(P.ws + WS_EG + du * 640 + lane * 16), (LAS unsigned*)(buf + SC_EG), 16, 0, 0);
                    asm volatile("s_waitcnt vmcnt(0)" ::: "memory");
                }
                WG_BAR_LDS();
            }
        } else {
            const int dvb = wave;
            f32x16 S[4];
#pragma unroll
            for (int k = 0; k < 4; ++k)
#pragma unroll
                for (int r = 0; r < 16; ++r) S[k][r] = 0.f;
            bf16* Od = (bf16*)(P.ws + WS_O) + (size_t)d * M * 1024;
            v4u un[4];
            { const int ci0 = d ? 31 : 0; const size_t du0 = (size_t)d * NUNIT + (b * 8 + h) * 32 + ci0; const v4u* UF = (const v4u*)(outb + OUT_UF + du0 * 16384);
#pragma unroll
              for (int ct = 0; ct < 2; ++ct) { un[2 * ct] = UF[((ct * 4 + dvb) * 64 + lane_) * 2]; un[2 * ct + 1] = UF[((ct * 4 + dvb) * 64 + lane_) * 2 + 1]; } }
            WG_BAR_LDS();
#pragma unroll 1
            for (int step = 0; step < 32; ++step) {
                int lane = lane_; asm volatile("" : "+v"(lane));
                const int hh = lane >> 5, r31 = lane & 31;
                const int ci = d ? 31 - step : step;
                const LAS unsigned char* buf = lds + (step & 1) * SC_BUF + lane * 16;
                const LAS float* rec = (const LAS float*)(lds + (step & 1) * SC_BUF + SC_EG);
                f32x16 va[2], oa[2];
#pragma unroll
                for (int ct = 0; ct < 2; ++ct) { const v4u u0 = un[2 * ct], u1 = un[2 * ct + 1];
                    va[ct][0] = bf_lo(u0.x); va[ct][1] = bf_hi(u0.x); va[ct][2] = bf_lo(u0.y); va[ct][3] = bf_hi(u0.y); va[ct][4] = bf_lo(u0.z); va[ct][5] = bf_hi(u0.z); va[ct][6] = bf_lo(u0.w); va[ct][7] = bf_hi(u0.w);
                    va[ct][8] = bf_lo(u1.x); va[ct][9] = bf_hi(u1.x); va[ct][10] = bf_lo(u1.y); va[ct][11] = bf_hi(u1.y); va[ct][12] = bf_lo(u1.z); va[ct][13] = bf_hi(u1.z); va[ct][14] = bf_lo(u1.w); va[ct][15] = bf_hi(u1.w);
#pragma unroll
                    for (int r = 0; r < 16; ++r) oa[ct][r] = 0.f; }
                if (step + 1 < 32) { const int cn = d ? 31 - (step + 1) : (step + 1); const size_t dun = (size_t)d * NUNIT + (b * 8 + h) * 32 + cn; const v4u* UF = (const v4u*)(outb + OUT_UF + dun * 16384);
#pragma unroll
                    for (int ct = 0; ct < 2; ++ct) { un[2 * ct] = UF[((ct * 4 + dvb) * 64 + lane) * 2]; un[2 * ct + 1] = UF[((ct * 4 + dvb) * 64 + lane) * 2 + 1]; } }
#pragma unroll
                for (int s8 = 0; s8 < 8; ++s8) { float sv[8];
#pragma unroll
                    for (int j = 0; j < 8; ++j) sv[j] = S[s8 >> 1][8 * (s8 & 1) + j];
                    const bf16x8v Sb = pack8(sv);
#pragma unroll
                    for (int ct = 0; ct < 2; ++ct) { va[ct] = mfma32(*(const LAS bf16x8v*)(buf + SC_WF + (ct * 8 + s8) * 1024), Sb, va[ct]); oa[ct] = mfma32(*(const LAS bf16x8v*)(buf + SC_QF + (ct * 8 + s8) * 1024), Sb, oa[ct]); } }
                bf16x8v vb[4], vs[4];
#pragma unroll
                for (int ct = 0; ct < 2; ++ct) {
#pragma unroll
                    for (int q4 = 0; q4 < 4; ++q4) { const f32x4 eg = *(const LAS f32x4*)(rec + 32 * ct + 8 * q4 + 4 * hh), el = *(const LAS f32x4*)(rec + 64 + 32 * ct + 8 * q4 + 4 * hh);
#pragma unroll
                        for (int e = 0; e < 4; ++e) oa[ct][4 * q4 + e] *= eg[e];
                        if (q4 & 1) { float p[8], sc[8];
#pragma unroll
                            for (int e = 0; e < 4; ++e) { p[4 + e] = va[ct][4 * q4 + e]; sc[4 + e] = p[4 + e] * el[e]; }
                            const f32x4 el0 = *(const LAS f32x4*)(rec + 64 + 32 * ct + 8 * (q4 - 1) + 4 * hh);
#pragma unroll
                            for (int e = 0; e < 4; ++e) { p[e] = va[ct][4 * (q4 - 1) + e]; sc[e] = p[e] * el0[e]; }
                            vb[2 * ct + (q4 >> 1)] = pack8(p); vs[2 * ct + (q4 >> 1)] = pack8(sc); } } }
#pragma unroll
                for (int s4 = 0; s4 < 4; ++s4)
#pragma unroll
                    for (int ct = 0; ct < 2; ++ct) oa[ct] = mfma32(*(const LAS bf16x8v*)(buf + SC_QKF + (ct * 4 + s4) * 1024), vb[s4], oa[ct]);
                const float egl = rec[128];
#pragma unroll
                for (int dkt = 0; dkt < 4; ++dkt) {
#pragma unroll
                    for (int r = 0; r < 16; ++r) S[dkt][r] *= egl;
#pragma unroll
                    for (int s4 = 0; s4 < 4; ++s4) S[dkt] = mfma32(*(const LAS bf16x8v*)(buf + SC_KTF + (dkt * 4 + s4) * 1024), vs[s4], S[dkt]); }
                bf16* op = Od + ((size_t)b * SEQ + ci * 64) * 1024 + h * HD + 32 * dvb + (r31 & ~1);
#pragma unroll
                for (int ct = 0; ct < 2; ++ct)
#pragma unroll
                    for (int r = 0; r < 16; r += 2) { const float a = oa[ct][r], bq = oa[ct][r + 1];
                        const float na = dpp_get<0xB1, 0xF>(a), nb = dpp_get<0xB1, 0xF>(bq);
                        const bool odd = r31 & 1; const unsigned w = odd ? pk2(nb, bq) : pk2(a, na);
                        *(unsigned*)(op + (size_t)(32 * ct + rowof(r + (odd ? 1 : 0), hh)) * 1024) = w; }
                WG_BAR_LDS();
            }
        }
        WG_BAR_LDS();
    }
}
__device__ __forceinline__ float row16_sum(float v) {
    v += dpp_get<0xB1, 0xF>(v); v += dpp_get<0x4E, 0xF>(v); v += dpp_get<0x141, 0xF>(v); v += dpp_get<0x140, 0xF>(v); return v; }
__device__ __forceinline__ void dn_combine(const Ptrs& P, int gw, int NGW, int lane) {
    const bf16* O = (const bf16*)(P.ws + WS_O); const bf16* Z = (const bf16*)(P.ws + WS_Z); bf16* Y = (bf16*)(P.ws + WS_XN);
    const int cl = 8 * (lane & 15);
    const f32x4 nw0 = *(const f32x4*)(P.dn_norm_w + cl), nw1 = *(const f32x4*)(P.dn_norm_w + cl + 4);
    const float nw[8] = {nw0[0], nw0[1], nw0[2], nw0[3], nw1[0], nw1[1], nw1[2], nw1[3]};
    for (int it0 = gw * 2; it0 < M * 2; it0 += NGW * 2) {
        v4u a[2], bq[2], zz[2]; size_t off[2];
#pragma unroll
        for (int k = 0; k < 2; ++k) { const int it = it0 + k, m = it >> 1, hq = it & 1; off[k] = (size_t)m * 1024 + (hq * 4 + (lane >> 4)) * HD + cl;
            a[k] = *(const v4u*)(O + off[k]); bq[k] = *(const v4u*)(O + (size_t)M * 1024 + off[k]); zz[k] = *(const v4u*)(Z + off[k]); }
#pragma unroll
        for (int k = 0; k < 2; ++k) { const int it = it0 + k, m = it >> 1;
            const unsigned aw[4] = {a[k].x, a[k].y, a[k].z, a[k].w}, bw[4] = {bq[k].x, bq[k].y, bq[k].z, bq[k].w}, zw[4] = {zz[k].x, zz[k].y, zz[k].z, zz[k].w};
            float o[8], z[8]; float ss = 0.f;
#pragma unroll
            for (int e = 0; e < 4; ++e) { o[2 * e] = bf_lo(aw[e]) + bf_lo(bw[e]); o[2 * e + 1] = bf_hi(aw[e]) + bf_hi(bw[e]); z[2 * e] = bf_lo(zw[e]); z[2 * e + 1] = bf_hi(zw[e]); ss += o[2 * e] * o[2 * e] + o[2 * e + 1] * o[2 * e + 1]; }
            const float rn = rsqrtf(row16_sum(ss) * (1.0f / HD) + RMS_EPS);
            float y[8];
#pragma unroll
            for (int e = 0; e < 8; ++e) y[e] = o[e] * rn * nw[e] * (z[e] * __builtin_amdgcn_rcpf(1.0f + __expf(-z[e])));
            v4u w; w.x = pk2(y[0], y[1]); w.y = pk2(y[2], y[3]); w.z = pk2(y[4], y[5]); w.w = pk2(y[6], y[7]);
            *(v4u*)(Y + (size_t)m * DM + 1024 + (off[k] - (size_t)m * 1024)) = w; }
    }
}

struct Args { const float* in[15]; float* out; unsigned char* ws; int pad0, pad1; };
typedef const __attribute__((address_space(4))) Args* KArgs;
__device__ __forceinline__ int lane_id_opaque() { int l; asm volatile("v_mbcnt_lo_u32_b32 %0, -1, 0\n\tv_mbcnt_hi_u32_b32 %0, -1, %0" : "=v"(l)); return l; }
__device__ __forceinline__ void load_ptrs(Ptrs& P, KArgs a) {
    asm volatile("" : "+s"(a));
    P.xp = a->in[0]; P.xs = a->in[1]; P.norm_mix_w = a->in[2]; P.w_in = a->in[3]; P.rpb = a->in[4]; P.conv_w = a->in[5]; P.A_log = a->in[6]; P.dt_bias = a->in[7];
    P.dn_norm_w = a->in[8]; P.w_out = a->in[9]; P.norm_ffn_w = a->in[10]; P.w_gate = a->in[11]; P.w_up = a->in[12]; P.w_down = a->in[13]; P.final_norm_w = a->in[14];
    P.out = a->out; P.ws = a->ws;
}
__global__ void __launch_bounds__(512, 2) fwd(Args args) {
    extern __shared__ __attribute__((aligned(16))) unsigned char lds_raw[];
    LAS unsigned char* lds = (LAS unsigned char*)lds_raw;
    const int wave = __builtin_amdgcn_readfirstlane(threadIdx.x >> 6);
    const KArgs ka = (KArgs)__builtin_amdgcn_kernarg_segment_ptr();
    const int G = gridDim.x, NGW = G * 8, gw = blockIdx.x * 8 + wave;
    XcdBarrier bar;
    { const int lane = lane_id_opaque(); const int tid = wave * 64 + lane;
      for (int u = tid; u < (LDS_BYTES - LDSCTL_OFF) / 4; u += 512) ((LAS unsigned*)(lds + LDSCTL_OFF))[u] = 0u;
      __syncthreads();
      bar = xcd_barrier_post(g_xbar, (volatile LAS unsigned*)(lds + MISC_OFF) + 8, tid == 0); }
#define SEAM() do { const int l_ = lane_id_opaque(); xcd_barrier(bar, wave == 0 && l_ == 0); } while (0)
#define PHASE_BEGIN() const int lane = lane_id_opaque(); const int tid = wave * 64 + lane; (void)tid; Ptrs P; load_ptrs(P, ka)

    { PHASE_BEGIN(); p0_prologue(P, lds, gw, NGW, wave, lane);
      for (int i = (int)blockIdx.x * 512 + tid; i < M; i += G * 512) ((unsigned long long*)(P.ws + WS_SSQ))[i] = 0ull; } SEAM();
    { PHASE_BEGIN();
        pg8::Gemm g{(const bf16*)(P.ws + WS_XN), (const bf16*)(P.ws + WS_W1), M, NPROJ, DM}; pg8::StaticOrder S; S.init(M, NPROJ, G, (int)blockIdx.x);
        pg8::EpiProj E{(bf16*)(P.ws + WS_PROJ), PROJ_STRIDE / 2, (bf16*)(P.ws + WS_Z), (float*)(P.ws + WS_BA)};
        pg8::gemm_phase<pg8::EpiProj, pg8::StaticOrder, PG8_ALIGN, PG8_SP2>(lds + RING_OFF, g, S, E, wave, lane);
        { const int rem = S.nwg % G; if (rem && (int)blockIdx.x >= rem) wconv_items(P, lds, IT_WO, IT_G, ((int)blockIdx.x - rem) * 8 + wave, (G - rem) * 8, wave, lane); }
    } SEAM();
    { PHASE_BEGIN(); na_mfma(P, lds, wave, lane); asm volatile("s_waitcnt vmcnt(0)" ::: "memory"); __syncthreads(); }
    { PHASE_BEGIN(); dn_pre2(P, lds, tid, wave, lane); } SEAM();
    { PHASE_BEGIN();
        if ((int)blockIdx.x >= NSEQ * NH * 2) wconv_items(P, lds, IT_G, IT_D, ((int)blockIdx.x - NSEQ * NH * 2) * 8 + wave, (G - NSEQ * NH * 2) * 8, wave, lane);
        else dn_scan2(P, lds, wave, lane);
    } SEAM();
    { PHASE_BEGIN(); dn_combine(P, gw, NGW, lane); } SEAM();
    { PHASE_BEGIN();
        pg8::Gemm g{(const bf16*)(P.ws + WS_XN), (const bf16*)(P.ws + WS_WO), M, DM, DM}; pg8::StaticOrder S; S.init(M, DM, G, (int)blockIdx.x);
        pg8::EpiResid E{P.xp, P.xs, (bf16*)(P.ws + WS_H16), (unsigned long long*)(P.ws + WS_SSQ)};
        pg8::gemm_phase<pg8::EpiResid, pg8::StaticOrder, PG8_ALIGN, PG8_SP2>(lds + RING_OFF, g, S, E, wave, lane);
    } SEAM();
    { PHASE_BEGIN();
        pg8::Gemm g{(const bf16*)(P.ws + WS_H16), (const bf16*)(P.ws + WS_W3), M, NGU, DM}; pg8::StaticOrder S; S.init(M, NGU, G, (int)blockIdx.x);
        pg8::Unit u0; u0.pm = 0; u0.pn = 0; (void)S.next(0, u0);
        LAS float* rsl = (LAS float*)(lds + RSTD_OFF);
        { const int sl = tid >> 7, pm = 8 * ((u0.pm >> 3) + sl) + (u0.pm & 7); unsigned long long* q = (unsigned long long*)(P.ws + WS_SSQ) + (size_t)pm * 256 + (tid & 127);
#pragma unroll
          for (int e = 0; e < 2; ++e) { float r = 0.f;
              if (pm < M / 256) r = rsqrtf((float)__hip_atomic_load(q + 128 * e, __ATOMIC_RELAXED, __HIP_MEMORY_SCOPE_AGENT) * (1.f / (SSQ_SCALE * DM)) + RMS_EPS);
              rsl[sl * 256 + (tid & 127) + 128 * e] = r; } }
        __syncthreads();
        pg8::EpiSwiGLU E{(bf16*)(P.ws + WS_ACT), rsl, u0.pm >> 3};
        pg8::gemm_phase<pg8::EpiSwiGLU, pg8::StaticOrder, PG8_ALIGN, PG8_SP2>(lds + RING_OFF, g, S, E, wave, lane);
        { const int rem = S.nwg % G; if (rem && (int)blockIdx.x >= rem) wconv_items(P, lds, IT_D, IT_END, ((int)blockIdx.x - rem) * 8 + wave, (G - rem) * 8, wave, lane); }
    } SEAM();
    { PHASE_BEGIN();
        pg8::Gemm g{(const bf16*)(P.ws + WS_ACT), (const bf16*)(P.ws + WS_W4), M, DM, DFF}; pg8::StaticOrder S; S.init(M, DM, G, (int)blockIdx.x);
        pg8::EpiDown E{(bf16*)(P.ws + WS_F16)};
        pg8::gemm_phase<pg8::EpiDown, pg8::StaticOrder, PG8_ALIGN, PG8_SP2>(lds + RING_OFF, g, S, E, wave, lane);
    } SEAM();
    { PHASE_BEGIN(); if (wave == 0) xcd_barrier_retire(bar, lane);
      for (int m = gw; m < M; m += NGW) rms_row_sum2_to_f32((const bf16*)(P.ws + WS_H16) + (size_t)m * DM, (const bf16*)(P.ws + WS_F16) + (size_t)m * DM, P.final_norm_w, P.out + (size_t)m * DM, lane); }
#undef SEAM
#undef PHASE_BEGIN
}

extern "C" void kernel_launch(void* const* d_in, const int* in_sizes, int n_in, void* d_out, int out_size, void* d_ws, size_t ws_size, hipStream_t stream) {
    static int grid = 0;
    if (grid == 0) {
        if (n_in != 15 || out_size != M * DM || ws_size < WS_END) { fprintf(stderr, "kernel_launch: unexpected shapes (n_in %d out %d ws %zu)\n", n_in, out_size, ws_size); grid = -1; return; }
        int dev = 0, cus = 0, per_cu = 0;
        if (hipGetDevice(&dev) != hipSuccess || hipDeviceGetAttribute(&cus, hipDeviceAttributeMultiprocessorCount, dev) != hipSuccess) { grid = -1; return; }
        if (cus != 256) { fprintf(stderr, "kernel_launch: built for 256 CUs (one resident 512-thread workgroup each), found %d\n", cus); grid = -1; return; }
        if (hipFuncSetAttribute((const void*)fwd, hipFuncAttributeMaxDynamicSharedMemorySize, LDS_BYTES) != hipSuccess) { grid = -1; return; }
        if (hipOccupancyMaxActiveBlocksPerMultiprocessor(&per_cu, (const void*)fwd, 512, LDS_BYTES) != hipSuccess || per_cu < 1) fprintf(stderr, "kernel_launch: occupancy query says %d\n", per_cu);
        (void)hipGetLastError();
        grid = cus;
    }
    if (grid < 0) return;
    Args a{};
    for (int i = 0; i < 15; ++i) a.in[i] = (const float*)d_in[i];
    a.out = (float*)d_out; a.ws = (unsigned char*)d_ws;
    hipLaunchKernelGGL(fwd, dim3(grid), dim3(512), LDS_BYTES, stream, a);
}
```

```cpp
#include <hip/hip_runtime.h>
#include <cstdio>
#include <cstdint>

namespace pg8 {
#define PG8_LAS __attribute__((address_space(3)))
typedef unsigned short bf16_t;
typedef short bf16x8 __attribute__((ext_vector_type(8)));
typedef float f32x4 __attribute__((ext_vector_type(4)));
typedef unsigned u32x4 __attribute__((ext_vector_type(4)));
constexpr int BM = 256, BK = 64, HALF = 128, HTB = HALF * BK * 2  , STAGE_BYTES = 8 * HTB, NXCD = 8, WGM = 8;

__host__ __device__ __forceinline__ int lds_byte(int r, int c) { const int st = (r >> 4) * 2 + (c >> 5), rr = r & 15, cc = c & 31, ob = rr * 64 + cc * 2; return st * 1024 + (ob ^ (((ob >> 9) & 1) << 5)); }
__host__ __device__ __forceinline__ void stage_rc(int b, int& R, int& C) { const int st = b / 1024, sb = b % 1024, swz = sb ^ (((sb >> 9) & 1) << 5); R = (st >> 1) * 16 + swz / 64; C = (st & 1) * 32 + (swz % 64) / 2; }
__host__ __device__ __forceinline__ int perm32(int rho) { const int n = rho >> 4, i = rho & 15; return 8 * (i >> 2) + 4 * n + (i & 3); }

struct Unit { int pm, pn; };
struct Gemm { const bf16_t* A; const bf16_t* Bt; int M, N, K; };

struct StaticOrder {
    int nM, nN, nwg, G, c;
    __host__ __device__ void init(int M, int N, int G_, int c_) { nM = M / BM; nN = N / BM; nwg = nM * nN; G = G_; c = c_; }
    __host__ __device__ bool next(int i, Unit& u) const {
        const long L = (long)i * G + c; if (L >= nwg) return false;
        int wgid = (int)L; { const int q = nwg / NXCD, r = nwg % NXCD, xcd = wgid % NXCD, off = wgid / NXCD; wgid = (xcd < r ? xcd * (q + 1) : r * (q + 1) + (xcd - r) * q) + off; }
        const int nig = WGM * nN, gid = wgid / nig, fm = gid * WGM, gsz = (nM - fm) < WGM ? (nM - fm) : WGM;
        u.pm = fm + ((wgid % nig) % gsz); u.pn = (wgid % nig) / gsz; return true;
    }
    __device__ __forceinline__ void a_ready(const Unit&) const {}
    __device__ __forceinline__ void done(const Unit&) const {}
};

__device__ __forceinline__ unsigned cvt_pk_bf16(float lo, float hi) { unsigned r; asm volatile("v_cvt_pk_bf16_f32 %0, %1, %2" : "=v"(r) : "v"(lo), "v"(hi)); return r; }
typedef float f32x2 __attribute__((ext_vector_type(2)));
template <class Epi, class Sched, bool ALIGN_EPI = false, bool SP2 = false>
__device__ __forceinline__ void gemm_phase(PG8_LAS unsigned char* lds, const Gemm g, const Sched& S, const Epi& E, const int wid, const int lane) {
    const int tid = wid * 64 + lane, wr = wid >> 2, wc = wid & 3, fr = lane & 15, fq = lane >> 4;
    const int K = g.K, nt = K / BK;
    unsigned voffA[2], voffB[2];
#pragma unroll
    for (int i = 0; i < 2; ++i) { int R, C; stage_rc(tid * 16 + i * 8192, R, C); const int Rb = Epi::PERM ? ((R & ~31) + perm32(R & 31)) : R;
        voffA[i] = (unsigned)(R * K + C) * 2u; voffB[i] = (unsigned)(Rb * K + C) * 2u; }
    const size_t kstep = (size_t)(BK * 2);
    const size_t hstep = (size_t)HALF * K * 2;
    const size_t tstep = 2 * hstep;
    const unsigned ldsw = (unsigned)wid * 1024u;
    const int aoff = lds_byte(wr * 64 + fr, fq * 8), boff = lds_byte(wc * 32 + fr, fq * 8);
#define PG8_SA(b, h) (((b) * 2 + (h)) * HTB)
#define PG8_SB(b, h) ((4 + (b) * 2 + (h)) * HTB)
#define PG8_STAGE(bufoff, gbase, voff) do { _Pragma("unroll") for (int _i = 0; _i < 2; ++_i) \
        __builtin_amdgcn_global_load_lds((const unsigned*)((const char*)(gbase) + (voff)[_i]), (PG8_LAS unsigned*)(lds + (bufoff) + ldsw + _i * 8192), 16, 0, 0); } while (0)
#define PG8_LDA(dst, b, h) do { _Pragma("unroll") for (int m = 0; m < 4; ++m) _Pragma("unroll") for (int k = 0; k < 2; ++k) dst[m][k] = *(const PG8_LAS bf16x8*)(lds + PG8_SA(b, h) + aoff + m * 2048 + k * 1024); } while (0)
#define PG8_LDB(dst, b, h) do { _Pragma("unroll") for (int n = 0; n < 2; ++n) _Pragma("unroll") for (int k = 0; k < 2; ++k) dst[n][k] = *(const PG8_LAS bf16x8*)(lds + PG8_SB(b, h) + boff + n * 2048 + k * 1024); } while (0)
#define PG8_MMA(ai, bj, At, Bt) do { __builtin_amdgcn_s_setprio(1); _Pragma("unroll") for (int m = 0; m < 4; ++m) _Pragma("unroll") for (int n = 0; n < 2; ++n) _Pragma("unroll") for (int k = 0; k < 2; ++k) \
        acc[ai][bj][m][n] = __builtin_amdgcn_mfma_f32_16x16x32_bf16(Bt[n][k], At[m][k], acc[ai][bj][m][n], 0, 0, 0); __builtin_amdgcn_s_setprio(0); } while (0)
#define PG8_WAIT_V(n) asm volatile("s_waitcnt vmcnt(" #n ")" ::: "memory")
#define PG8_WAIT_L(n) asm volatile("s_waitcnt lgkmcnt(" #n ")" ::: "memory")
#define PG8_BAR __builtin_amdgcn_s_barrier()
#define PG8_SCHED __builtin_amdgcn_sched_barrier(0)
    Unit cur, nxt; int ui = 0;
    if (!S.next(0, cur)) return;
    f32x4 acc[2][2][4][2];
#pragma unroll
    for (int a = 0; a < 2; ++a)
#pragma unroll
        for (int b = 0; b < 2; ++b)
#pragma unroll
            for (int m = 0; m < 4; ++m)
#pragma unroll
                for (int n = 0; n < 2; ++n) acc[a][b][m][n] = (f32x4){0.f, 0.f, 0.f, 0.f};
    bf16x8 At[4][2], B0[2][2], B1[2][2];
    const char* cA = (const char*)g.A + (size_t)cur.pm * tstep; const char* cB = (const char*)g.Bt + (size_t)cur.pn * tstep;
    S.a_ready(cur);
    if constexpr (SP2) {
        PG8_STAGE(PG8_SB(0, 0), cB, voffB); PG8_STAGE(PG8_SB(0, 1), cB + hstep, voffB); PG8_STAGE(PG8_SA(0, 0), cA, voffA); PG8_STAGE(PG8_SA(0, 1), cA + hstep, voffA);
        if (wr == 1) PG8_BAR;
        PG8_WAIT_V(2); PG8_BAR;
        PG8_STAGE(PG8_SB(1, 0), cB + kstep, voffB); PG8_STAGE(PG8_SA(1, 0), cA + kstep, voffA); PG8_STAGE(PG8_SB(1, 1), cB + hstep + kstep, voffB);
        PG8_WAIT_V(6); PG8_BAR;
    } else {
        PG8_STAGE(PG8_SB(0, 0), cB, voffB); PG8_STAGE(PG8_SA(0, 0), cA, voffA); PG8_STAGE(PG8_SB(0, 1), cB + hstep, voffB); PG8_STAGE(PG8_SA(0, 1), cA + hstep, voffA);
        if (wr == 1) PG8_BAR;
        PG8_WAIT_V(4); PG8_BAR;
        PG8_STAGE(PG8_SB(1, 0), cB + kstep, voffB); PG8_STAGE(PG8_SA(1, 0), cA + kstep, voffA); PG8_STAGE(PG8_SB(1, 1), cB + hstep + kstep, voffB);
        PG8_WAIT_V(6); PG8_BAR;
    }
    for (;;) {
        const bool has_next = S.next(ui + 1, nxt);
        const char* nA = has_next ? (const char*)g.A + (size_t)nxt.pm * tstep : cA; const char* nB = has_next ? (const char*)g.Bt + (size_t)nxt.pn * tstep : cB;
        for (int t = 0; t < nt; t += 2) {
            const bool last = (t == nt - 2);
            const char* a1 = cA + (size_t)(t + 1) * kstep;
            const char* a2 = last ? nA : cA + (size_t)(t + 2) * kstep; const char* b2 = last ? nB : cB + (size_t)(t + 2) * kstep;
            const char* a3 = a2 + kstep; const char* b3 = b2 + kstep;
            if (last && has_next) S.a_ready(nxt);
            if constexpr (SP2) {
            PG8_LDB(B0, 0, 0); PG8_LDB(B1, 0, 1); PG8_SCHED; PG8_LDA(At, 0, 0); PG8_STAGE(PG8_SA(1, 1), a1 + hstep, voffA);
            PG8_WAIT_V(8); PG8_WAIT_L(0); PG8_BAR; PG8_MMA(0, 0, At, B0); PG8_MMA(0, 1, At, B1); PG8_BAR; PG8_SCHED;
            PG8_LDA(At, 0, 1); PG8_STAGE(PG8_SB(0, 0), b2, voffB); PG8_STAGE(PG8_SB(0, 1), b2 + hstep, voffB); PG8_STAGE(PG8_SA(0, 0), a2, voffA);
            PG8_WAIT_V(8); PG8_WAIT_L(0); PG8_BAR; PG8_MMA(1, 0, At, B0); PG8_MMA(1, 1, At, B1); PG8_BAR; PG8_SCHED;
            PG8_LDB(B0, 1, 0); PG8_LDB(B1, 1, 1); PG8_SCHED; PG8_LDA(At, 1, 0); PG8_STAGE(PG8_SA(0, 1), a2 + hstep, voffA);
            PG8_WAIT_V(8); PG8_WAIT_L(0); PG8_BAR; PG8_MMA(0, 0, At, B0); PG8_MMA(0, 1, At, B1); PG8_BAR; PG8_SCHED;
            PG8_LDA(At, 1, 1); PG8_STAGE(PG8_SB(1, 0), b3, voffB); PG8_STAGE(PG8_SB(1, 1), b3 + hstep, voffB); PG8_STAGE(PG8_SA(1, 0), a3, voffA);
            PG8_WAIT_V(8); PG8_WAIT_L(0); PG8_BAR; PG8_MMA(1, 0, At, B0); PG8_MMA(1, 1, At, B1); PG8_BAR; PG8_SCHED;
            } else {
            PG8_LDB(B0, 0, 0); PG8_SCHED; PG8_LDA(At, 0, 0); PG8_STAGE(PG8_SA(1, 1), a1 + hstep, voffA);
            PG8_WAIT_L(8); PG8_BAR; PG8_WAIT_L(0); PG8_MMA(0, 0, At, B0); PG8_BAR; PG8_SCHED;
            PG8_LDB(B1, 0, 1); PG8_STAGE(PG8_SB(0, 0), b2, voffB);
            PG8_BAR; PG8_WAIT_L(0); PG8_MMA(0, 1, At, B1); PG8_BAR;
            PG8_LDA(At, 0, 1); PG8_STAGE(PG8_SA(0, 0), a2, voffA);
            PG8_BAR; PG8_WAIT_L(0); PG8_MMA(1, 0, At, B0); PG8_BAR; PG8_SCHED;
            PG8_STAGE(PG8_SB(0, 1), b2 + hstep, voffB);
            PG8_WAIT_V(6); PG8_BAR; PG8_MMA(1, 1, At, B1); PG8_BAR;
            PG8_LDB(B0, 1, 0); PG8_SCHED; PG8_LDA(At, 1, 0); PG8_STAGE(PG8_SA(0, 1), a2 + hstep, voffA);
            PG8_WAIT_L(8); PG8_BAR; PG8_WAIT_L(0); PG8_MMA(0, 0, At, B0); PG8_BAR; PG8_SCHED;
            PG8_LDB(B1, 1, 1); PG8_STAGE(PG8_SB(1, 0), b3, voffB);
            PG8_BAR; PG8_WAIT_L(0); PG8_MMA(0, 1, At, B1); PG8_BAR;
            PG8_LDA(At, 1, 1); PG8_STAGE(PG8_SA(1, 0), a3, voffA);
            PG8_BAR; PG8_WAIT_L(0); PG8_MMA(1, 0, At, B0); PG8_BAR; PG8_SCHED;
            PG8_STAGE(PG8_SB(1, 1), b3 + hstep, voffB);
            PG8_WAIT_V(6); PG8_BAR; PG8_MMA(1, 1, At, B1); PG8_BAR;
            }
        }
        if constexpr (ALIGN_EPI) { if (wr == 0) PG8_BAR; }
        if constexpr (!Epi::AFTER_DRAIN) { E(acc, cur, wr, wc, fr, fq); S.done(cur); }
        if (!has_next) break;
#pragma unroll
        for (int a = 0; a < 2; ++a)
#pragma unroll
            for (int b = 0; b < 2; ++b)
#pragma unroll
                for (int m = 0; m < 4; ++m)
#pragma unroll
                    for (int n = 0; n < 2; ++n) acc[a][b][m][n] = (f32x4){0.f, 0.f, 0.f, 0.f};
        cur = nxt; cA = nA; cB = nB; ++ui;
        if constexpr (ALIGN_EPI) { if (wr == 1) PG8_BAR; }
    }
    PG8_WAIT_V(0);
    if constexpr (!ALIGN_EPI) { if (wr == 0) PG8_BAR; }
    PG8_BAR;
    if constexpr (Epi::AFTER_DRAIN) { E.fused(acc, cur, wr, wc, fr, fq, lds, wid, lane); S.done(cur); }
#undef PG8_SA
#undef PG8_SB
#undef PG8_STAGE
#undef PG8_LDA
#undef PG8_LDB
#undef PG8_MMA
#undef PG8_WAIT_V
#undef PG8_WAIT_L
#undef PG8_BAR
#undef PG8_SCHED
}
}

constexpr int DM = 2048, SEQ = 2048, NSEQ = 12, M = NSEQ * SEQ, MP = 8 * SEQ;
constexpr int NIN = 7200, NPROJ = 7424;
constexpr int DFF = 5632, NGU = 2 * DFF;
constexpr int HD = 128, NH = 8;
constexpr float RMS_EPS = 1e-6f, L2_EPS = 1e-6f, QSCALE = 0.08838834764831845f;

constexpr size_t MiB = 1u << 20;
constexpr size_t WS_CTL = 0;
constexpr size_t WS_BA = 1 * MiB;
constexpr size_t WS_WO = 4 * MiB, WS_W1 = 12 * MiB, WS_W3 = 41 * MiB, WS_W4 = 85 * MiB;
constexpr size_t WS_XN = 112 * MiB;
constexpr size_t WS_PROJ = 208 * MiB, PROJ_STRIDE = 48 * MiB;
constexpr size_t WS_O = 352 * MiB;
constexpr size_t WS_PRE = 576 * MiB;
constexpr size_t WS_Z = 720 * MiB;
constexpr size_t WS_ACT = 208 * MiB;
constexpr size_t WS_H16 = 576 * MiB;
constexpr size_t WS_F16 = 672 * MiB;
constexpr size_t WS_END = 768 * MiB;
constexpr size_t WS_SSQ = 256 * 1024;
constexpr float SSQ_SCALE = 1048576.f;

constexpr int RING_OFF = 0, RING_BYTES = 131072;
constexpr int LDSCTL_OFF = 163328, MISC_OFF = LDSCTL_OFF + 320;
constexpr int RSTD_OFF = RING_BYTES;
constexpr int LDS_BYTES = 163840;

#define GAS __attribute__((address_space(1)))
#define LAS __attribute__((address_space(3)))
typedef unsigned short bf16;
typedef unsigned v4u __attribute__((ext_vector_type(4)));
typedef unsigned v2u __attribute__((ext_vector_type(2)));
typedef float f32x4 __attribute__((ext_vector_type(4)));
typedef float f32x2 __attribute__((ext_vector_type(2)));
typedef GAS unsigned gu32;
#define RLX_AGENT __ATOMIC_RELAXED, __HIP_MEMORY_SCOPE_AGENT
#define LDS_WAIT() asm volatile("s_waitcnt lgkmcnt(0)" ::: "memory")
#define VM_WAIT() asm volatile("s_waitcnt vmcnt(0)" ::: "memory")

__device__ __forceinline__ float bf_lo(unsigned v) { return __uint_as_float(v << 16); }
__device__ __forceinline__ float bf_hi(unsigned v) { return __uint_as_float(v & 0xffff0000u); }
__device__ __forceinline__ float bf2f(bf16 b) { return __uint_as_float(((unsigned)b) << 16); }
typedef __bf16 bf16x2_t __attribute__((ext_vector_type(2)));
__device__ __forceinline__ unsigned pk2(float lo, float hi) { bf16x2_t v; v[0] = (__bf16)lo; v[1] = (__bf16)hi; return __builtin_bit_cast(unsigned, v); }
template <int CTRL, int RM> __device__ __forceinline__ float dpp_get(float v) { return __builtin_bit_cast(float, __builtin_amdgcn_update_dpp(0, __builtin_bit_cast(int, v), CTRL, RM, 0xF, false)); }
__device__ __forceinline__ float wave_sum(float v) {
    v += dpp_get<0xB1, 0xF>(v); v += dpp_get<0x4E, 0xF>(v); v += dpp_get<0x141, 0xF>(v); v += dpp_get<0x140, 0xF>(v);
    v += dpp_get<0x142, 0xA>(v); v += dpp_get<0x143, 0xC>(v);
    return __builtin_bit_cast(float, __builtin_amdgcn_readlane(__builtin_bit_cast(int, v), 63));
}
__device__ __forceinline__ float wave_max(float v) {
#pragma unroll
    for (int o = 1; o < 64; o <<= 1) v = fmaxf(v, __shfl_xor(v, o));
    return v;
}
__device__ __forceinline__ float silu_f(float x) { return x * __builtin_amdgcn_rcpf(1.0f + __expf(-x)); }
__device__ __forceinline__ float sigmoid_f(float x) { return 1.0f / (1.0f + expf(-x)); }
__device__ __forceinline__ float softplus_f(float x) { return fmaxf(x, 0.f) + log1pf(expf(-fabsf(x))); }

namespace pg8 {
typedef unsigned u32x2 __attribute__((ext_vector_type(2)));
struct EpiProj {
    static constexpr bool PERM = true, AFTER_DRAIN = false;
    bf16_t* P; size_t stride; bf16_t* Z; float* BA;
    __device__ __forceinline__ void operator()(const f32x4 (&acc)[2][2][4][2], const Unit& u, int wr, int wc, int fr, int fq) const {
        const int row0 = u.pm * BM + wr * 64 + fr;
        if (u.pn < 28) {
            const int t = u.pn >> 2; bf16_t* base = (t < 6) ? P + (size_t)t * stride : Z;
            const int col0 = (u.pn & 3) * BM + wc * 32 + 8 * fq;
#pragma unroll
            for (int ai = 0; ai < 2; ++ai)
#pragma unroll
                for (int m = 0; m < 4; ++m) { bf16_t* rowp = base + (size_t)(row0 + ai * HALF + m * 16) * 1024 + col0;
#pragma unroll
                    for (int bj = 0; bj < 2; ++bj) { const f32x4 v0 = acc[ai][bj][m][0], v1 = acc[ai][bj][m][1];
                        u32x4 w; w.x = cvt_pk_bf16(v0[0], v0[1]); w.y = cvt_pk_bf16(v0[2], v0[3]); w.z = cvt_pk_bf16(v1[0], v1[1]); w.w = cvt_pk_bf16(v1[2], v1[3]);
                        *(u32x4*)(rowp + bj * HALF) = w; } }
        } else if (wc == 0) {
#pragma unroll
            for (int ai = 0; ai < 2; ++ai)
#pragma unroll
                for (int m = 0; m < 4; ++m) { float* rowp = BA + (size_t)(row0 + ai * HALF + m * 16) * 32 + 8 * fq;
                    *(f32x4*)(rowp) = acc[ai][0][m][0]; *(f32x4*)(rowp + 4) = acc[ai][0][m][1]; }
        }
    }
};
struct EpiResid {
    static constexpr bool PERM = true, AFTER_DRAIN = false;
    const float* xp; const float* xs; bf16_t* H; unsigned long long* ssq;
    __device__ __forceinline__ void operator()(const f32x4 (&acc)[2][2][4][2], const Unit& u, int wr, int wc, int fr, int fq) const {
        const int row0 = u.pm * BM + wr * 64 + fr, col0 = u.pn * BM + wc * 32 + 8 * fq;
        const float* xb = (u.pm * BM < MP) ? xp : xs - (size_t)MP * DM;
        float rs[8];
#pragma unroll
        for (int ai = 0; ai < 2; ++ai)
#pragma unroll
            for (int m = 0; m < 4; ++m) { const size_t off = (size_t)(row0 + ai * HALF + m * 16) * DM + col0; float sq = 0.f;
#pragma unroll
                for (int bj = 0; bj < 2; ++bj) { const f32x4 h0 = *(const f32x4*)(xb + off + bj * HALF) + acc[ai][bj][m][0], h1 = *(const f32x4*)(xb + off + bj * HALF + 4) + acc[ai][bj][m][1];
                    sq += ((h0[0] * h0[0] + h0[1] * h0[1]) + (h0[2] * h0[2] + h0[3] * h0[3])) + ((h1[0] * h1[0] + h1[1] * h1[1]) + (h1[2] * h1[2] + h1[3] * h1[3]));
                    u32x4 w; w.x = cvt_pk_bf16(h0[0], h0[1]); w.y = cvt_pk_bf16(h0[2], h0[3]); w.z = cvt_pk_bf16(h1[0], h1[1]); w.w = cvt_pk_bf16(h1[2], h1[3]);
                    *(u32x4*)(H + off + bj * HALF) = w; }
                rs[ai * 4 + m] = sq; }
#pragma unroll
        for (int j = 0; j < 8; ++j) { rs[j] += __shfl_xor(rs[j], 16); rs[j] += __shfl_xor(rs[j], 32); }
        const float v0 = fq == 0 ? rs[0] : fq == 1 ? rs[2] : fq == 2 ? rs[4] : rs[6], v1 = fq == 0 ? rs[1] : fq == 1 ? rs[3] : fq == 2 ? rs[5] : rs[7];
        unsigned long long* q = ssq + (u.pm * BM + (fq >> 1) * HALF + wr * 64 + (fq & 1) * 32 + fr);
        (void)__hip_atomic_fetch_add(q, (unsigned long long)(v0 * SSQ_SCALE + 0.5f), __ATOMIC_RELAXED, __HIP_MEMORY_SCOPE_AGENT);
        (void)__hip_atomic_fetch_add(q + 16, (unsigned long long)(v1 * SSQ_SCALE + 0.5f), __ATOMIC_RELAXED, __HIP_MEMORY_SCOPE_AGENT);
    }
};
struct EpiDown {
    static constexpr bool PERM = true, AFTER_DRAIN = false;
    bf16_t* O;
    __device__ __forceinline__ void operator()(const f32x4 (&acc)[2][2][4][2], const Unit& u, int wr, int wc, int fr, int fq) const {
        const int row0 = u.pm * BM + wr * 64 + fr, col0 = u.pn * BM + wc * 32 + 8 * fq;
#pragma unroll
        for (int ai = 0; ai < 2; ++ai)
#pragma unroll
            for (int m = 0; m < 4; ++m) { bf16_t* rowp = O + (size_t)(row0 + ai * HALF + m * 16) * DM + col0;
#pragma unroll
                for (int bj = 0; bj < 2; ++bj) { const f32x4 v0 = acc[ai][bj][m][0], v1 = acc[ai][bj][m][1];
                    u32x4 w; w.x = cvt_pk_bf16(v0[0], v0[1]); w.y = cvt_pk_bf16(v0[2], v0[3]); w.z = cvt_pk_bf16(v1[0], v1[1]); w.w = cvt_pk_bf16(v1[2], v1[3]);
                    *(u32x4*)(rowp + bj * HALF) = w; } }
    }
};
struct EpiSwiGLU {
    static constexpr bool PERM = true, AFTER_DRAIN = false;
    bf16_t* O; const __attribute__((address_space(3))) float* rs; int g0;
    __device__ __forceinline__ void operator()(const f32x4 (&acc)[2][2][4][2], const Unit& u, int wr, int wc, int fr, int fq) const {
        const int row0 = u.pm * BM + wr * 64 + fr, col0 = u.pn * HALF + wc * 32 + 8 * fq;
        float rv[8];
#pragma unroll
        for (int j = 0; j < 8; ++j) rv[j] = rs[((u.pm >> 3) - g0) * BM + wr * 64 + fr + (j >> 2) * HALF + (j & 3) * 16];
        asm volatile("s_waitcnt lgkmcnt(0)" ::: "memory");
#pragma unroll
        for (int ai = 0; ai < 2; ++ai)
#pragma unroll
            for (int m = 0; m < 4; ++m) { bf16_t* rowp = O + (size_t)(row0 + ai * HALF + m * 16) * DFF + col0;
                const float rstd = rv[ai * 4 + m];
                float r[8];
#pragma unroll
                for (int n = 0; n < 2; ++n)
#pragma unroll
                    for (int j = 0; j < 4; ++j) { const float g = acc[ai][0][m][n][j] * rstd, up = acc[ai][1][m][n][j] * rstd; r[4 * n + j] = g * __builtin_amdgcn_rcpf(1.0f + __expf(-g)) * up; }
                u32x4 w; w.x = cvt_pk_bf16(r[0], r[1]); w.y = cvt_pk_bf16(r[2], r[3]); w.z = cvt_pk_bf16(r[4], r[5]); w.w = cvt_pk_bf16(r[6], r[7]);
                *(u32x4*)rowp = w; }
    }
};
}

#ifndef PG8_SP2
#define PG8_SP2 true
#endif
#ifndef PG8_ALIGN
#define PG8_ALIGN true
#endif

#define XB_TMO      128
#define XB_XCNT(j)  (256  + 64 * (j))
#define XB_XSUB(j)  (1280 + 64 * (j))
#define XB_XGEN(j)  (2304 + 64 * (j))
#define XB_TOP      3328
#define XB_TOPGEN   3392
#define XB_EXIT     3424
#define XCD_BAR_WORDS 3456
#define XB_SPIN_CAP (1u << 18)

__device__ __forceinline__ unsigned xb_ld(unsigned* p)              { return __hip_atomic_load(p, __ATOMIC_RELAXED, __HIP_MEMORY_SCOPE_AGENT); }
__device__ __forceinline__ unsigned xb_add(unsigned* p, unsigned v) { return __hip_atomic_fetch_add(p, v, __ATOMIC_RELAXED, __HIP_MEMORY_SCOPE_AGENT); }
__device__ __forceinline__ unsigned xb_xcc_id() { return (unsigned)__builtin_amdgcn_s_getreg((3 << 11) | 20) & 0xFu; }
#define XB_SPIN(cond, bar) do { unsigned _sp = 0; while (cond) { __builtin_amdgcn_s_sleep(1); \
    if ((++_sp & 255u) == 0u) { if (xb_ld(&(bar)[XB_TMO])) break; if (_sp > XB_SPIN_CAP) { atomicAdd(&(bar)[XB_TMO], 1u); break; } } } } while (0)

struct XcdBarrier {
    unsigned* bar; unsigned x;
    volatile LAS unsigned* st;
};

__device__ __forceinline__ XcdBarrier xcd_barrier_post(unsigned* bar, volatile LAS unsigned* st, const bool t0) {
    XcdBarrier b; b.bar = bar; b.x = xb_xcc_id(); b.st = st;
    if (t0) (void)xb_add(&bar[XB_XCNT(b.x)], 1u);
    return b;
}
__device__ __forceinline__ void xcd_barrier_complete(unsigned* bar, unsigned x, unsigned& nloc, unsigned& nx) {
    const unsigned G = gridDim.x * gridDim.y * gridDim.z;
    unsigned sum, cnt, mine, sp = 0u;
    for (;;) {
        sum = 0u; cnt = 0u; mine = 0u;
#pragma unroll
        for (unsigned j = 0; j < 16; ++j) { const unsigned c = xb_ld(&bar[XB_XCNT(j)]); sum += c; cnt += (c > 0u) ? 1u : 0u; mine = (j == x) ? c : mine; }
        if (sum == G) break;
        __builtin_amdgcn_s_sleep(1);
        if ((++sp & 255u) == 0u) { if (xb_ld(&bar[XB_TMO])) break; if (sp > XB_SPIN_CAP) { atomicAdd(&bar[XB_TMO], 1u); break; } }
    }
    nloc = mine > 0u ? mine : 1u; nx = cnt > 0u ? cnt : 1u;
}

__device__ __forceinline__ void xcd_barrier(const XcdBarrier& b, const bool t0) {
    asm volatile("s_waitcnt vmcnt(0)" ::: "memory");
    __syncthreads();
    if (t0) {
        unsigned* bar = b.bar;
        __builtin_amdgcn_s_waitcnt(0);
        unsigned nloc = b.st[0], nx = b.st[1];
        if (nloc == 0u) { xcd_barrier_complete(bar, b.x, nloc, nx); b.st[0] = nloc; b.st[1] = nx; }
        const unsigned k = b.st[2]; b.st[2] = k + 1u;
        const unsigned old = xb_add(&bar[XB_XSUB(b.x)], 1u);
        if (old + 1u == (old / nloc + 1u) * nloc) {
            __builtin_amdgcn_fence(__ATOMIC_RELEASE, "agent");
            asm volatile("s_waitcnt vmcnt(0)" ::: "memory");
            (void)xb_add(&bar[XB_TOP], 1u);
        }
        XB_SPIN(xb_ld(&bar[XB_TOP]) < (k + 1u) * nx, bar);
        __builtin_amdgcn_fence(__ATOMIC_ACQUIRE, "agent");
        asm volatile("s_waitcnt vmcnt(0)" ::: "memory");
    }
    __syncthreads();
}


__device__ unsigned g_xbar[XCD_BAR_WORDS];
__device__ __forceinline__ void xcd_barrier_retire(const XcdBarrier& b, const int lane) {
    unsigned last = 0u;
    if (lane == 0) { b.st[2] = 0u; last = (xb_add(&b.bar[XB_EXIT], 1u) + 1u == gridDim.x * gridDim.y * gridDim.z) ? 1u : 0u; }
    last = (unsigned)__builtin_amdgcn_readfirstlane((int)last);
    if (last) for (unsigned i = (unsigned)lane; i < XCD_BAR_WORDS; i += 64u) __hip_atomic_store(&b.bar[i], 0u, __ATOMIC_RELAXED, __HIP_MEMORY_SCOPE_AGENT);
}

struct TrItem { const float* W; const float* ks; bf16* WT; int ldw, ldt, k0, n0, drow; };
__device__ __forceinline__ void tr_load(const TrItem& t, int lane, f32x4 (&v)[8], f32x4 (&kg)[2]) {
    const GAS float* p = (const GAS float*)t.W + (size_t)(t.k0 + (lane >> 3)) * t.ldw + t.n0 + 4 * (lane & 7);
#pragma unroll
    for (int i = 0; i < 8; ++i) v[i] = *(const GAS f32x4*)(p + (size_t)(8 * i) * t.ldw);
    kg[0] = kg[1] = (f32x4){1.f, 1.f, 1.f, 1.f};
    if (t.ks) { const GAS f32x4* kp = (const GAS f32x4*)(t.ks + t.k0 + 8 * (lane & 7)); kg[0] = kp[0]; kg[1] = kp[1]; }
}
__device__ __forceinline__ void tr_store(const TrItem& t, int lane, const f32x4 (&v)[8], const f32x4 (&kg)[2], LAS float* scr) {
    LAS float* w = scr + (lane >> 3) * 33 + 4 * (lane & 7);
#pragma unroll
    for (int i = 0; i < 8; ++i)
#pragma unroll
        for (int e = 0; e < 4; ++e) w[(8 * i) * 33 + e] = v[i][e];
    LDS_WAIT(); asm volatile("" ::: "memory");
    const int c = lane & 7;
#pragma unroll
    for (int j = 0; j < 4; ++j) { const int n = (lane >> 3) + 8 * j; const LAS float* s = scr + (8 * c) * 33 + n;
        v4u o; o.x = pk2(s[0 * 33] * kg[0][0], s[1 * 33] * kg[0][1]); o.y = pk2(s[2 * 33] * kg[0][2], s[3 * 33] * kg[0][3]); o.z = pk2(s[4 * 33] * kg[1][0], s[5 * 33] * kg[1][1]); o.w = pk2(s[6 * 33] * kg[1][2], s[7 * 33] * kg[1][3]);
        *(GAS v4u*)(t.WT + (size_t)(t.drow + n) * t.ldt + t.k0 + 8 * c) = o; }
    LDS_WAIT(); asm volatile("" ::: "memory");
}
__device__ __forceinline__ void rms_row_to_bf16(const float* xrow, const float* w, bf16* orow, int lane) {
    const f32x4* xr = (const f32x4*)xrow + lane; const f32x4* wr = (const f32x4*)w + lane;
    f32x4 v[8]; float s = 0.f;
#pragma unroll
    for (int j = 0; j < 8; ++j) { v[j] = xr[64 * j]; s += (v[j].x * v[j].x + v[j].y * v[j].y) + (v[j].z * v[j].z + v[j].w * v[j].w); }
    const float rstd = rsqrtf(wave_sum(s) * (1.f / DM) + RMS_EPS);
    v2u* o8 = (v2u*)orow + lane;
#pragma unroll
    for (int j = 0; j < 8; ++j) { const f32x4 g = wr[64 * j]; v2u o; o.x = pk2(v[j].x * rstd * g.x, v[j].y * rstd * g.y); o.y = pk2(v[j].z * rstd * g.z, v[j].w * rstd * g.w); o8[64 * j] = o; }
}
__device__ __forceinline__ void rms_row_sum2_to_f32(const bf16* hrow, const bf16* frow, const float* w, float* orow, int lane) {
    const v4u* hr = (const v4u*)hrow + lane; const v4u* fr_ = (const v4u*)frow + lane; const f32x4* wr = (const f32x4*)w;
    float v[4][8]; float s = 0.f;
#pragma unroll
    for (int j = 0; j < 4; ++j) { const v4u q = hr[64 * j], f = fr_[64 * j];
        v[j][0] = bf_lo(q.x) + bf_lo(f.x); v[j][1] = bf_hi(q.x) + bf_hi(f.x); v[j][2] = bf_lo(q.y) + bf_lo(f.y); v[j][3] = bf_hi(q.y) + bf_hi(f.y);
        v[j][4] = bf_lo(q.z) + bf_lo(f.z); v[j][5] = bf_hi(q.z) + bf_hi(f.z); v[j][6] = bf_lo(q.w) + bf_lo(f.w); v[j][7] = bf_hi(q.w) + bf_hi(f.w);
#pragma unroll
        for (int e = 0; e < 8; ++e) s += v[j][e] * v[j][e]; }
    const float rstd = rsqrtf(wave_sum(s) * (1.f / DM) + RMS_EPS);
    f32x4* o4 = (f32x4*)orow;
#pragma unroll
    for (int j = 0; j < 4; ++j) { const int i4 = 2 * (lane + 64 * j); const f32x4 g0 = wr[i4], g1 = wr[i4 + 1];
        o4[i4] = (f32x4){v[j][0] * rstd * g0[0], v[j][1] * rstd * g0[1], v[j][2] * rstd * g0[2], v[j][3] * rstd * g0[3]};
        o4[i4 + 1] = (f32x4){v[j][4] * rstd * g1[0], v[j][5] * rstd * g1[1], v[j][6] * rstd * g1[2], v[j][7] * rstd * g1[3]}; }
}
struct Ptrs {
    const float *xp, *xs, *norm_mix_w, *w_in, *rpb, *conv_w, *A_log, *dt_bias, *dn_norm_w, *w_out, *norm_ffn_w, *w_gate, *w_up, *w_down, *final_norm_w;
    float* out; unsigned char* ws;
};

constexpr int I_1 = (DM / 64) * (NIN / 32), I_O = (DM / 64) * (DM / 32), I_G = (DM / 64) * (DFF / 32), I_D = (DFF / 64) * (DM / 32);
constexpr int IT_W1 = 0, IT_WO = I_1, IT_G = I_1 + I_O, IT_D = I_1 + I_O + 2 * I_G, IT_END = IT_D + I_D;
__device__ __forceinline__ TrItem tr_decode(const Ptrs& P, int r) {
    TrItem t;
    if (r < I_1) { const int nb = r % (NIN / 32), kb = r / (NIN / 32); t.W = P.w_in; t.ks = nullptr; t.ldw = NIN; t.k0 = 64 * kb; t.n0 = 32 * nb; t.WT = (bf16*)(P.ws + WS_W1); t.ldt = DM; t.drow = 32 * nb; return t; } r -= I_1;
    if (r < I_O) { const int nb = r % (DM / 32), kb = r / (DM / 32); t.W = P.w_out; t.ks = nullptr; t.ldw = DM; t.k0 = 64 * kb; t.n0 = 32 * nb; t.WT = (bf16*)(P.ws + WS_WO); t.ldt = DM; t.drow = 32 * nb; return t; } r -= I_O;
    if (r < 2 * I_G) { const int up = r >= I_G; if (up) r -= I_G; const int nb = r % (DFF / 32), kb = r / (DFF / 32); const int n0 = 32 * nb;
        t.W = up ? P.w_up : P.w_gate; t.ks = P.norm_ffn_w; t.ldw = DFF; t.k0 = 64 * kb; t.n0 = n0; t.WT = (bf16*)(P.ws + WS_W3); t.ldt = DM; t.drow = 256 * (n0 >> 7) + (n0 & 127) + (up ? 128 : 0); return t; } r -= 2 * I_G;
    { const int nb = r % (DM / 32), kb = r / (DM / 32); t.W = P.w_down; t.ks = nullptr; t.ldw = DM; t.k0 = 64 * kb; t.n0 = 32 * nb; t.WT = (bf16*)(P.ws + WS_W4); t.ldt = DFF; t.drow = 32 * nb; return t; }
}
__device__ __forceinline__ void wconv_items(const Ptrs& P, LAS unsigned char* lds, int first, int last, int gwi, int ngwi, int wave, int lane) {
    LAS float* scr = (LAS float*)(lds + RING_OFF + wave * 16384);
    int it = first + gwi; if (it >= last) return;
#define WC_CL(i) ((i) < last ? (i) : it)
    TrItem a0 = tr_decode(P, it), b0 = tr_decode(P, WC_CL(it + ngwi)), a1, b1;
    f32x4 va0[8], vb0[8], va1[8], vb1[8], ka0[2], kb0[2], ka1[2], kb1[2];
    tr_load(a0, lane, va0, ka0); tr_load(b0, lane, vb0, kb0);
    for (;;) {
        const int i1 = it + 2 * ngwi; const bool m1 = i1 < last;
        a1 = tr_decode(P, m1 ? i1 : it); b1 = tr_decode(P, (m1 && i1 + ngwi < last) ? i1 + ngwi : (m1 ? i1 : it));
        tr_load(a1, lane, va1, ka1); tr_load(b1, lane, vb1, kb1);
        tr_store(a0, lane, va0, ka0, scr); tr_store(b0, lane, vb0, kb0, scr);
        if (!m1) break;
        const int i2 = i1 + 2 * ngwi; const bool m2 = i2 < last;
        a0 = tr_decode(P, m2 ? i2 : i1); b0 = tr_decode(P, (m2 && i2 + ngwi < last) ? i2 + ngwi : (m2 ? i2 : i1));
        tr_load(a0, lane, va0, ka0); tr_load(b0, lane, vb0, kb0);
        tr_store(a1, lane, va1, ka1, scr); tr_store(b1, lane, vb1, kb1, scr);
        if (!m2) break;
        it = i2;
    }
#undef WC_CL
}
__device__ __forceinline__ void p0_prologue(const Ptrs& P, LAS unsigned char* lds, int gw, int NGW, int wave, int lane) {
    wconv_items(P, lds, IT_W1, IT_WO, gw, NGW, wave, lane);
    bf16* W1t = (bf16*)(P.ws + WS_W1);
    { const v4u z = {0u, 0u, 0u, 0u}; v4u* zp = (v4u*)(W1t + (size_t)NIN * DM);
      for (int i = gw * 64 + lane; i < (NPROJ - NIN) * DM / 8; i += NGW * 64) zp[i] = z; }
    bf16* XN = (bf16*)(P.ws + WS_XN);
    for (int m = gw; m < M; m += NGW) { const float* xr = (m < MP) ? P.xp + (size_t)m * DM : P.xs + (size_t)(m - MP) * DM; rms_row_to_bf16(xr, P.norm_mix_w, XN + (size_t)m * DM, lane); }
}

#define WG_BAR_LDS() do { asm volatile("s_waitcnt lgkmcnt(0)" ::: "memory"); __builtin_amdgcn_s_barrier(); asm volatile("" ::: "memory"); } while (0)
typedef short s16x4 __attribute__((ext_vector_type(4)));
typedef short bf16x8v __attribute__((ext_vector_type(8)));
constexpr int NA_VST = 288, NA_VBUF = 32 * NA_VST;
constexpr float NA_LAZY = 8.0f;
constexpr int NA_KST = 272, NA_KIMG = 32 * NA_KST, NA_VIMG = 32 * NA_VST, NA_BUF = NA_KIMG + NA_VIMG, NA_BT = 4 * NA_BUF;
struct NaGeo { int qb, h, b, rg; };
__device__ __forceinline__ NaGeo na_geo(int task, int G) {
    const int blk = task % G, rnd = task / G, mem = (blk >> 3) & 15, bh = rnd * 16 + (blk & 7) * 2 + (blk >> 7), ty = mem >> 2;
    NaGeo g; g.qb = mem & 3; g.h = bh & 7; g.b = bh >> 3; g.rg = rnd == 4 ? (0xB4 >> (2 * ty)) & 3 : rnd == 5 ? (0x2D >> (2 * ty)) & 3 : (ty + rnd) & 3; return g;
}
__device__ __forceinline__ void na_mfma(const Ptrs& P, LAS unsigned char* lds, int wave, int lane_) {
    const bf16* Q = (const bf16*)(P.ws + WS_PROJ); const bf16* K = (const bf16*)(P.ws + WS_PROJ + PROJ_STRIDE); const bf16* V = (const bf16*)(P.ws + WS_PROJ + 2 * PROJ_STRIDE);
    bf16* Y = (bf16*)(P.ws + WS_XN);
    LAS float* BT = (LAS float*)(lds + NA_BT);
    int bt_head = -1;
    const int G_ = (int)gridDim.x, NTASK = NSEQ * NH * 4 * 4;
    bf16x8v nQf[4]; v4u nsk0, nsv0, nsk1, nsv1;
#define NA_NEXT(ge_) do { int ln_ = lane_; asm volatile("" : "+v"(ln_)); const int t_ = wave * 64 + ln_; const NaGeo e_ = (ge_); \
        const size_t tq_ = (size_t)e_.b * SEQ + (8 * e_.rg + wave) * 64 + 16 * e_.qb + (ln_ & 15); \
        _Pragma("unroll") for (int ks = 0; ks < 4; ++ks) nQf[ks] = *(const bf16x8v*)(Q + tq_ * 1024 + e_.h * HD + 32 * ks + 8 * (ln_ >> 4)); \
        const int kl_ = min(max(8 * e_.rg - 4, 0), 24); \
        const size_t sb_ = ((size_t)e_.b * SEQ + min(max(16 * e_.qb - 8, 0), 32) + (t_ >> 4)) * 1024 + e_.h * HD + 8 * (t_ & 15) + (size_t)kl_ * 64 * 1024; \
        nsk0 = *(const v4u*)(K + sb_); nsv0 = *(const v4u*)(V + sb_); nsk1 = *(const v4u*)(K + sb_ + 64 * 1024); nsv1 = *(const v4u*)(V + sb_ + 64 * 1024); } while (0)
    NaGeo gnext = na_geo((int)blockIdx.x, G_);
    NA_NEXT(gnext);
    for (int task = blockIdx.x; task < NTASK; task += G_) {
        int lane = lane_; asm volatile("" : "+v"(lane));
        const int fr = lane & 15, g = lane >> 4, tid = wave * 64 + lane;
        const NaGeo ge = gnext;
        const int qb = ge.qb, h = ge.h, b = ge.b, rg = ge.rg;
        const bool has_next = task + G_ < NTASK;
        if (has_next) gnext = na_geo(task + G_, G_);
        const int r = 8 * rg + wave, rs = min(max(r - 4, 0), 24), kb0 = min(max(16 * qb - 8, 0), 32);
        const int kr_lo = min(max(8 * rg - 4, 0), 24), kr_hi = min(max(8 * rg + 3, 0), 24) + 7;
        const int c = 16 * qb + fr, cs = min(max(c - 8, 0), 48);
        const size_t tq = (size_t)b * SEQ + r * 64 + c;
        const int skey = tid >> 4, spart = tid & 15;
        const size_t sbase = ((size_t)b * SEQ + kb0 + skey) * 1024 + h * HD + 8 * spart;
        const int kofs = skey * NA_KST + spart * 16, vofs = NA_KIMG + skey * NA_VST + spart * 16;
#define NA_LD(kr_, sk_, sv_) do { const size_t o_ = sbase + (size_t)min((kr_), kr_hi) * 64 * 1024; sk_ = *(const v4u*)(K + o_); sv_ = *(const v4u*)(V + o_); } while (0)
        v4u skPa, svPa, skPb, svPb, skQa, svQa, skQb, svQb;
        NA_LD(kr_lo + 2, skPa, svPa); NA_LD(kr_lo + 3, skPb, svPb); NA_LD(kr_lo + 4, skQa, svQa); NA_LD(kr_lo + 5, skQb, svQb);
        bf16x8v Qf[4];
#pragma unroll
        for (int ks = 0; ks < 4; ++ks) Qf[ks] = nQf[ks];
        const v4u sk0 = nsk0, sv0 = nsv0, sk1 = nsk1, sv1 = nsv1;
        const bool bt_new = (h != bt_head); float bias_in = 0.f;
        if (bt_new && tid < 465) bias_in = P.rpb[h * 465 + tid];
        WG_BAR_LDS();
        *(LAS v4u*)(lds + kofs) = sk0; *(LAS v4u*)(lds + vofs) = sv0; *(LAS v4u*)(lds + NA_BUF + kofs) = sk1; *(LAS v4u*)(lds + NA_BUF + vofs) = sv1;
        if (bt_new && tid < 465) BT[tid] = bias_in;
        bt_head = h;
        f32x4 O[8];
#pragma unroll
        for (int dt = 0; dt < 8; ++dt) O[dt] = (f32x4){0.f, 0.f, 0.f, 0.f};
        float mrun = -INFINITY, lrun = 0.f;
        int bi[8]; bool bv[8];
#pragma unroll
        for (int e = 0; e < 4; ++e) { const int kc0 = kb0 + 4 * g + e, kc1 = kc0 + 16; bv[e] = (kc0 >= cs) && (kc0 < cs + 16); bv[4 + e] = (kc1 >= cs) && (kc1 < cs + 16);
            bi[e] = min(max(kc0 - c + 15, 0), 30); bi[4 + e] = min(max(kc1 - c + 15, 0), 30); }
        WG_BAR_LDS();
#define NA_ROW(kr_) do { const int kr = (kr_); \
            if (kr >= rs && kr < rs + 8) { LAS unsigned char* buf = lds + ((kr - kr_lo) & 3) * NA_BUF; \
                  \
                const unsigned vtr = (unsigned)(size_t)(buf + NA_KIMG) + (unsigned)((4 * g + ((lane & 15) >> 2)) * NA_VST + (lane & 3) * 8); \
                s16x4 lo[8], hi[8]; \
                _Pragma("unroll") for (int d = 0; d < 8; ++d) { \
                    asm volatile("ds_read_b64_tr_b16 %0, %1 offset:%c2" : "=&v"(lo[d]) : "v"(vtr), "i"(d * 32) : "memory"); \
                    asm volatile("ds_read_b64_tr_b16 %0, %1 offset:%c2" : "=&v"(hi[d]) : "v"(vtr), "i"(d * 32 + 16 * NA_VST) : "memory"); } \
                  \
                const unsigned kpa = (unsigned)(size_t)(buf + fr * NA_KST + 16 * g), bra = (unsigned)(size_t)(BT + (kr - r + 7) * 31); \
                bf16x8v kf[8]; float bb[8]; \
                _Pragma("unroll") for (int ks = 0; ks < 4; ++ks) { \
                    asm volatile("ds_read_b128 %0, %1 offset:%c2" : "=&v"(kf[2 * ks]) : "v"(kpa), "i"(64 * ks) : "memory"); \
                    asm volatile("ds_read_b128 %0, %1 offset:%c2" : "=&v"(kf[2 * ks + 1]) : "v"(kpa), "i"(16 * NA_KST + 64 * ks) : "memory"); } \
                _Pragma("unroll") for (int e = 0; e < 8; ++e) asm volatile("ds_read_b32 %0, %1" : "=&v"(bb[e]) : "v"(bra + 4u * (unsigned)bi[e]) : "memory"); \
                asm volatile("s_waitcnt lgkmcnt(0)" ::: "memory"); __builtin_amdgcn_sched_barrier(0); \
                f32x4 s0 = {0.f, 0.f, 0.f, 0.f}, s1 = {0.f, 0.f, 0.f, 0.f}; \
                _Pragma("unroll") for (int ks = 0; ks < 4; ++ks) { s0 = __builtin_amdgcn_mfma_f32_16x16x32_bf16(kf[2 * ks], Qf[ks], s0, 0, 0, 0); \
                    s1 = __builtin_amdgcn_mfma_f32_16x16x32_bf16(kf[2 * ks + 1], Qf[ks], s1, 0, 0, 0); } \
                float mx = -INFINITY; \
                _Pragma("unroll") for (int e = 0; e < 4; ++e) { s0[e] = bv[e] ? s0[e] * QSCALE + bb[e] : -INFINITY; s1[e] = bv[4 + e] ? s1[e] * QSCALE + bb[4 + e] : -INFINITY; mx = fmaxf(mx, fmaxf(s0[e], s1[e])); } \
                if (__builtin_amdgcn_ballot_w64(mx > mrun + NA_LAZY) != 0ull) {          \
                    mx = fmaxf(mx, __shfl_xor(mx, 16)); mx = fmaxf(mx, __shfl_xor(mx, 32)); \
                    const float mnew = fmaxf(mrun, mx), alpha = __expf(mrun - mnew); \
                    lrun *= alpha; mrun = mnew; \
                    _Pragma("unroll") for (int dt = 0; dt < 8; ++dt) O[dt] = O[dt] * alpha; } \
                _Pragma("unroll") for (int e = 0; e < 4; ++e) { s0[e] = __expf(s0[e] - mrun); s1[e] = __expf(s1[e] - mrun); lrun += s0[e] + s1[e]; } \
                v4u pw; pw.x = pk2(s0[0], s0[1]); pw.y = pk2(s0[2], s0[3]); pw.z = pk2(s1[0], s1[1]); pw.w = pk2(s1[2], s1[3]); \
                const bf16x8v Pf = __builtin_bit_cast(bf16x8v, pw); \
                _Pragma("unroll") for (int d = 0; d < 8; ++d) { const bf16x8v Vf = (bf16x8v){lo[d][0], lo[d][1], lo[d][2], lo[d][3], hi[d][0], hi[d][1], hi[d][2], hi[d][3]}; \
                    O[d] = __builtin_amdgcn_mfma_f32_16x16x32_bf16(Vf, Pf, O[d], 0, 0, 0); } \
            } } while (0)
#define NA_DSTEP(k0_, skWa, svWa, skWb, svWb) do { const int k0 = (k0_); \
            if (has_next && k0 <= kr_hi && k0 + 2 > kr_hi) NA_NEXT(gnext);          \
            NA_ROW(k0); NA_ROW(k0 + 1); \
            if (k0 + 2 <= kr_hi) { LAS unsigned char* nb = lds + ((k0 + 2 - kr_lo) & 3) * NA_BUF; *(LAS v4u*)(nb + kofs) = skWa; *(LAS v4u*)(nb + vofs) = svWa; } \
            if (k0 + 3 <= kr_hi) { LAS unsigned char* nb = lds + ((k0 + 3 - kr_lo) & 3) * NA_BUF; *(LAS v4u*)(nb + kofs) = skWb; *(LAS v4u*)(nb + vofs) = svWb; } \
            NA_LD(k0 + 6, skWa, svWa); NA_LD(k0 + 7, skWb, svWb);               \
            WG_BAR_LDS(); } while (0)
#pragma unroll 1
        for (int k4 = kr_lo; k4 <= kr_hi; k4 += 4) {
            NA_DSTEP(k4, skPa, svPa, skPb, svPb); NA_DSTEP(k4 + 2, skQa, svQa, skQb, svQb);
        }
#undef NA_DSTEP
#undef NA_ROW
#undef NA_LD
        lrun += __shfl_xor(lrun, 16); lrun += __shfl_xor(lrun, 32);
        const float inv = 1.0f / lrun;
        bf16* yp = Y + tq * DM + h * HD + 4 * g;
#pragma unroll
        for (int dt = 0; dt < 8; ++dt) { v2u o; o.x = pk2(O[dt][0] * inv, O[dt][1] * inv); o.y = pk2(O[dt][2] * inv, O[dt][3] * inv); *(v2u*)(yp + 16 * dt) = o; }
    }
#undef NA_NEXT
}
typedef float f32x16 __attribute__((ext_vector_type(16)));
constexpr int IST = 272;
constexpr int L_QI = 0, L_KI = 17408, L_VI = 34816, TST = 136, TIMG = 64 * TST;
constexpr size_t WS_EG = 544 * MiB;
constexpr size_t PRE_QF = WS_PRE, PRE_KTF = WS_PRE + 48 * MiB, PRE_QKF = WS_PRE + 96 * MiB;
constexpr size_t OUT_WF = 0, OUT_UF = 96 * MiB;
constexpr int NUNIT = NSEQ * NH * 32;
__device__ __forceinline__ int rowof(int reg, int hh) { return (reg & 3) + 8 * (reg >> 2) + 4 * hh; }
__device__ __forceinline__ f32x16 mfma32(bf16x8v a, bf16x8v b, f32x16 c) { return __builtin_amdgcn_mfma_f32_32x32x16_bf16(a, b, c, 0, 0, 0); }
__device__ __forceinline__ bf16x8v pack8(const float* v) { v4u w; w.x = pk2(v[0], v[1]); w.y = pk2(v[2], v[3]); w.z = pk2(v[4], v[5]); w.w = pk2(v[6], v[7]); return __builtin_bit_cast(bf16x8v, w); }
__device__ __forceinline__ void split8(const float* v, bf16x8v& hi, bf16x8v& lo) {
    float r[8]; v4u w; w.x = pk2(v[0], v[1]); w.y = pk2(v[2], v[3]); w.z = pk2(v[4], v[5]); w.w = pk2(v[6], v[7]); hi = __builtin_bit_cast(bf16x8v, w);
    r[0] = v[0] - bf_lo(w.x); r[1] = v[1] - bf_hi(w.x); r[2] = v[2] - bf_lo(w.y); r[3] = v[3] - bf_hi(w.y); r[4] = v[4] - bf_lo(w.z); r[5] = v[5] - bf_hi(w.z); r[6] = v[6] - bf_lo(w.w); r[7] = v[7] - bf_hi(w.w);
    lo = pack8(r);
}
__device__ __forceinline__ bf16x8v pi_frag(const LAS unsigned char* img, int stride, int row0, int col0, int lane) {
    const LAS unsigned char* p = img + (row0 + (lane & 31)) * stride + (col0 + 4 * (lane >> 5)) * 2;
    const v2u a = *(const LAS v2u*)p, b = *(const LAS v2u*)(p + 16); v4u w; w.x = a.x; w.y = a.y; w.z = b.x; w.w = b.y; return __builtin_bit_cast(bf16x8v, w);
}
__device__ __forceinline__ bf16x8v tr_frag(unsigned img_addr, int stride, int krow0, int col0, int lane) {
    const unsigned a = img_addr + (unsigned)((krow0 + 4 * (lane >> 5) + ((lane & 15) >> 2)) * stride + (col0 + 16 * ((lane >> 4) & 1) + 4 * (lane & 3)) * 2);
    s16x4 lo, hi;
    asm volatile("ds_read_b64_tr_b16 %0, %1" : "=&v"(lo) : "v"(a) : "memory");
    asm volatile("ds_read_b64_tr_b16 %0, %1" : "=&v"(hi) : "v"(a + (unsigned)(8 * stride)) : "memory");
    asm volatile("s_waitcnt lgkmcnt(0)" ::: "memory"); __builtin_amdgcn_sched_barrier(0);
    return (bf16x8v){lo[0], lo[1], lo[2], lo[3], hi[0], hi[1], hi[2], hi[3]};
}
constexpr int P2_SET = 52224, P2_AM = 2 * P2_SET, P2_XT = P2_AM + 16384, P2_VEC = P2_XT + 17408, P2_CW = P2_VEC + 4096;
static_assert(P2_CW + 7680 <= LDSCTL_OFF, "pipelined pre-phase LDS map");
template <bool REV> __device__ __forceinline__ void dn_solve_a(const LAS float* AM, LAS float* XT, float (&x)[32], f32x16& Th, int lane) {
    const int blk = lane >> 5, c = lane & 31, hh = lane >> 5;
#pragma unroll
    for (int i = 0; i < 32; ++i) {
        float acc = (i == c) ? 1.f : 0.f;
        int rofs = (REV ? 63 - 32 * blk - i : 32 * blk + i) * 64;
        if (i >= 3) asm volatile("" : "+v"(rofs) : "v"(x[i - 3]));
        const LAS float* rp = AM + rofs;
#pragma unroll
        for (int qd = 0; qd < (i + 3) / 4; ++qd) {
            const f32x4 a = REV ? *(const LAS f32x4*)(rp + 60 - 32 * blk - 4 * qd) : *(const LAS f32x4*)(rp + 32 * blk + 4 * qd);
#pragma unroll
            for (int e = 0; e < 4; ++e) if (4 * qd + e < i) acc -= (REV ? a[3 - e] : a[e]) * x[4 * qd + e];
        }
        x[i] = acc;
    }
#pragma unroll
    for (int qd = 0; qd < 8; ++qd) *(LAS f32x4*)(XT + lane * 32 + 4 * qd) = (f32x4){x[4 * qd], x[4 * qd + 1], x[4 * qd + 2], x[4 * qd + 3]};
    LDS_WAIT();
    f32x16 Pm;
#pragma unroll
    for (int r = 0; r < 16; ++r) Pm[r] = 0.f;
#pragma unroll
    for (int s = 0; s < 2; ++s) {
        float av[8], bv[8];
        const LAS float* rp = AM + (REV ? 31 - c : 32 + c) * 64;
        if (REV) { const f32x4 alo = *(const LAS f32x4*)(rp + 56 - 16 * s - 8 * hh), ahi = *(const LAS f32x4*)(rp + 60 - 16 * s - 8 * hh);
            av[0] = ahi[3]; av[1] = ahi[2]; av[2] = ahi[1]; av[3] = ahi[0]; av[4] = alo[3]; av[5] = alo[2]; av[6] = alo[1]; av[7] = alo[0]; }
        else { const f32x4 a0 = *(const LAS f32x4*)(rp + 16 * s + 8 * hh), a1 = *(const LAS f32x4*)(rp + 16 * s + 8 * hh + 4);
            av[0] = a0[0]; av[1] = a0[1]; av[2] = a0[2]; av[3] = a0[3]; av[4] = a1[0]; av[5] = a1[1]; av[6] = a1[2]; av[7] = a1[3]; }
        { const f32x4 b0 = *(const LAS f32x4*)(XT + c * 32 + 16 * s + 8 * hh), b1 = *(const LAS f32x4*)(XT + c * 32 + 16 * s + 8 * hh + 4);
            bv[0] = b0[0]; bv[1] = b0[1]; bv[2] = b0[2]; bv[3] = b0[3]; bv[4] = b1[0]; bv[5] = b1[1]; bv[6] = b1[2]; bv[7] = b1[3]; }
        bf16x8v ah, al, bh, bl; split8(av, ah, al); split8(bv, bh, bl);
        Pm = mfma32(ah, bh, Pm); Pm = mfma32(ah, bl, Pm); Pm = mfma32(al, bh, Pm);
    }
#pragma unroll
    for (int r = 0; r < 16; ++r) Th[r] = 0.f;
#pragma unroll
    for (int s = 0; s < 2; ++s) {
        float av[8], pv[8];
#pragma unroll
        for (int j = 0; j < 8; ++j) { const int k = 16 * s + 8 * (j >> 2) + 4 * hh + (j & 3); av[j] = XT[(32 + k) * 32 + c]; pv[j] = Pm[8 * s + j]; }
        bf16x8v ah, al, ph, pl; split8(av, ah, al); split8(pv, ph, pl);
        Th = mfma32(ah, ph, Th); Th = mfma32(ah, pl, Th); Th = mfma32(al, ph, Th);
    }
    LDS_WAIT();
}
template <bool REV> __device__ __forceinline__ void dn_solve_b(const float (&x)[32], const f32x16& Th, const LAS float* BETA, const LAS float* BG, const LAS float* NK, LAS unsigned char* TB, int lane) {
    LAS unsigned char* TBG = TB + TIMG;
    { const v4u z = {0u, 0u, 0u, 0u};
#pragma unroll
      for (int i = 0; i < 17; ++i) *(LAS v4u*)(TB + (lane + 64 * i) * 16) = z; }
    LDS_WAIT();
    const int blk = lane >> 5, c = lane & 31, hh = lane >> 5;
    { const int colo = REV ? 63 - (32 * blk + c) : 32 * blk + c; const float sb = BETA[colo], sg = BG[colo] * NK[colo];
#pragma unroll
        for (int i = 0; i < 32; ++i) { const int rowo = REV ? 63 - (32 * blk + i) : 32 * blk + i;
            *(LAS unsigned short*)(TB + rowo * TST + colo * 2) = (unsigned short)(pk2(x[i] * sb, 0.f) & 0xffffu); *(LAS unsigned short*)(TBG + rowo * TST + colo * 2) = (unsigned short)(pk2(x[i] * sg, 0.f) & 0xffffu); } }
    { const int colo = REV ? 63 - c : c; const float sb = BETA[colo], sg = BG[colo] * NK[colo];
#pragma unroll
        for (int r = 0; r < 16; ++r) { const int i = 32 + rowof(r, hh); const int rowo = REV ? 63 - i : i; const float v = -Th[r];
            *(LAS unsigned short*)(TB + rowo * TST + colo * 2) = (unsigned short)(pk2(v * sb, 0.f) & 0xffffu); *(LAS unsigned short*)(TBG + rowo * TST + colo * 2) = (unsigned short)(pk2(v * sg, 0.f) & 0xffffu); } }
}
__device__ __forceinline__ void dn_pre2(const Ptrs& P, LAS unsigned char* lds, int tid_, int wave, int lane_) {
    const bf16* DNX = (const bf16*)(P.ws + WS_PROJ + 3 * PROJ_STRIDE); const float* BA = (const float*)(P.ws + WS_BA);
    unsigned char* outb = (unsigned char*)P.out;
    const unsigned ldsa = (unsigned)(size_t)lds;
    LAS float* CW = (LAS float*)(lds + P2_CW);
    const int G = gridDim.x; const int u0 = blockIdx.x;
    if (u0 >= NUNIT) return;
    const int hfix = (u0 >> 5) & 7;
    float c_aexp = 0.f, c_dtb = 0.f;
    unsigned xr[3][20]; float ba_b = 0.f, ba_a = 0.f;
#define P2_REQ(un_) do { const int chunk2 = (un_) & 31, h2 = ((un_) >> 5) & 7, b2 = (un_) >> 8; const int t02 = chunk2 * 64; \
        if (wave >= 2 && wave < 6) { _Pragma("unroll") for (int x = 0; x < 3; ++x) { const bf16* X = DNX + (size_t)x * (PROJ_STRIDE / 2) + h2 * HD + 2 * lane; \
            _Pragma("unroll") for (int i = 0; i < 20; ++i) { const int t = t02 + 16 * (wave - 2) - 2 + i; xr[x][i] = (t >= 0 && t < SEQ) ? *(const unsigned*)(X + ((size_t)b2 * SEQ + t) * 1024) : 0u; } } } \
        if (wave >= 6) { const size_t m2 = (size_t)b2 * SEQ + t02 + lane; ba_b = BA[m2 * 32 + (wave - 6) * 8 + h2]; ba_a = BA[m2 * 32 + 16 + (wave - 6) * 8 + h2]; } } while (0)
#define P2_S1T(un_, set_, T0_, T1_, GATES_, REQ_) do { \
        if (wave >= 2 && wave < 6) { \
            _Pragma("unroll") for (int x = 0; x < 3; ++x) { f32x2 cw[5]; \
                _Pragma("unroll") for (int j = 0; j < 5; ++j) cw[j] = *(const LAS f32x2*)(CW + (x * 5 + j) * 128 + 2 * lane); \
                f32x2 xf[20]; _Pragma("unroll") for (int i = (T0_); i < (T1_) + 4; ++i) xf[i] = (f32x2){bf_lo(xr[x][i]), bf_hi(xr[x][i])}; \
                _Pragma("unroll") for (int tt = (T0_); tt < (T1_); ++tt) { f32x2 yy = cw[0] * xf[tt]; \
                    _Pragma("unroll") for (int j = 1; j < 5; ++j) yy = __builtin_elementwise_fma(cw[j], xf[tt + j], yy); \
                    float y0 = yy.x, y1 = yy.y; \
                    y0 = y0 * __builtin_amdgcn_rcpf(1.0f + __expf(-y0)); y1 = y1 * __builtin_amdgcn_rcpf(1.0f + __expf(-y1)); \
                    *(LAS unsigned*)(lds + (set_) * P2_SET + x * 17408 + (16 * (wave - 2) + tt) * IST + 4 * lane) = pk2(y0, y1); } } } \
        if ((GATES_) && wave >= 6) { const int d = wave - 6; LAS float* VEC = (LAS float*)(lds + P2_VEC + (set_) * 2048); \
            const float beta = sigmoid_f(ba_b); float Gs = -c_aexp * softplus_f(ba_a + c_dtb); \
            if (d == 0) { _Pragma("unroll") for (int o = 1; o < 64; o <<= 1) { const float t = __shfl_up(Gs, o); if (lane >= o) Gs += t; } } \
            else { _Pragma("unroll") for (int o = 1; o < 64; o <<= 1) { const float t = __shfl_down(Gs, o); if (lane + o < 64) Gs += t; } } \
            const float eG = expf(Gs); \
            VEC[d * 64 + lane] = beta; VEC[128 + d * 64 + lane] = beta * eG; VEC[256 + d * 64 + lane] = Gs; } \
        if ((REQ_) && (un_) + G < NUNIT) P2_REQ((un_) + G); } while (0)
#define P2_S1(un_, set_) P2_S1T(un_, set_, 0, 16, 1, 1)
    constexpr int P2_TS = 16;
    int lane = lane_, tid = tid_;
    for (int i = tid; i < 3 * 5 * 128; i += 512) { const int x = i / 640, j = (i / 128) % 5, ch = i & 127; CW[i] = P.conv_w[(size_t)j * 3072 + x * 1024 + hfix * HD + ch]; }
    if (wave >= 6) { c_aexp = expf(P.A_log[(wave - 6) * 8 + hfix]); c_dtb = P.dt_bias[(wave - 6) * 8 + hfix]; }
    P2_REQ(u0);
    WG_BAR_LDS();
    P2_S1(u0, 0);
    int it = 0;
    for (int u = u0; u < NUNIT; u += G, ++it) {
        lane = lane_; tid = tid_; asm volatile("" : "+v"(lane), "+v"(tid));
        const int r31 = lane & 31, hh = lane >> 5; const int set = it & 1;
        LAS unsigned char* IMG = lds + set * P2_SET; const unsigned imga = ldsa + set * P2_SET;
        LAS float* VEC = (LAS float*)(lds + P2_VEC + set * 2048);
        LAS float* AM = (LAS float*)(lds + P2_AM);
        WG_BAR_LDS();
        { const int ta = (wave >> 1) & 1, tb = wave & 1;
            const LAS unsigned char* ab = IMG + L_KI + (32 * ta + r31) * IST + 16 * hh; const LAS unsigned char* bb = IMG + (wave < 4 ? L_KI : L_QI) + (32 * tb + r31) * IST + 16 * hh;
            f32x16 acc;
#pragma unroll
            for (int r = 0; r < 16; ++r) acc[r] = 0.f;
#pragma unroll
            for (int s8 = 0; s8 < 8; ++s8) acc = mfma32(*(const LAS bf16x8v*)(ab + 32 * s8), *(const LAS bf16x8v*)(bb + 32 * s8), acc);
            if (wave == 0 || wave == 3 || wave == 4 || wave == 5) {
                f32x16 dq = acc;
                if (wave >= 4) { const LAS unsigned char* qb_ = IMG + L_QI + (32 * (wave - 4) + r31) * IST + 16 * hh;
#pragma unroll
                    for (int r = 0; r < 16; ++r) dq[r] = 0.f;
#pragma unroll
                    for (int s8 = 0; s8 < 8; ++s8) dq = mfma32(*(const LAS bf16x8v*)(qb_ + 32 * s8), *(const LAS bf16x8v*)(qb_ + 32 * s8), dq); }
                float dv = 0.f;
#pragma unroll
                for (int r = 0; r < 16; ++r) if (rowof(r, hh) == r31) dv = dq[r];
                const int trow = (wave >= 4) ? 32 * (wave - 4) : 32 * ta;
                if (((r31 >> 2) & 1) == hh) { const float rn = rsqrtf(dv + L2_EPS); if (wave >= 4) VEC[384 + trow + r31] = rn * QSCALE; else VEC[448 + trow + r31] = rn; }
            }
            WG_BAR_LDS();
            if (wave < 4) {
                const int j = 32 * tb + r31; const float Gj0 = VEC[256 + j], Gj1 = VEC[256 + 64 + j], nkj = VEC[448 + j];
#pragma unroll
                for (int q4 = 0; q4 < 4; ++q4) { const int ib = 32 * ta + 8 * q4 + 4 * hh;
                    const f32x4 be0 = *(const LAS f32x4*)(VEC + ib), be1 = *(const LAS f32x4*)(VEC + 64 + ib), nk4 = *(const LAS f32x4*)(VEC + 448 + ib), g0 = *(const LAS f32x4*)(VEC + 256 + ib), g1 = *(const LAS f32x4*)(VEC + 320 + ib);
#pragma unroll
                    for (int e = 0; e < 4; ++e) { const int i = ib + e; const bool d = i < j;
                        const float v = (d ? be1[e] : be0[e]) * nk4[e] * nkj * acc[4 * q4 + e] * __expf(fminf((d ? g1[e] - Gj1 : g0[e] - Gj0), 0.f));
                        AM[i * 64 + j] = (i == j) ? 0.f : v; } }
                if (wave == 1 || wave == 2) { const int d = wave - 1; const float Gc = VEC[256 + d * 64 + lane], Gl = VEC[256 + d * 64 + (d ? 0 : 63)];
                    float* rec = (float*)(P.ws + WS_EG) + ((size_t)d * NUNIT + u) * 160;
                    rec[lane] = __expf(Gc) * VEC[384 + lane]; rec[64 + lane] = __expf(Gl - Gc) * VEC[448 + lane]; if (lane == 0) rec[128] = __expf(Gl); }
            } else {
                const int cc = 32 * tb + r31; const float nqc = VEC[384 + cc], Gc0 = VEC[256 + cc], Gc1 = VEC[320 + cc];
#pragma unroll
                for (int sf = 0; sf < 2; ++sf) { float v0[8], v1[8];
#pragma unroll
                    for (int jj = 0; jj < 2; ++jj) { const int cb = 32 * ta + 16 * sf + 8 * jj + 4 * hh;
                        const f32x4 nk4 = *(const LAS f32x4*)(VEC + 448 + cb), g0 = *(const LAS f32x4*)(VEC + 256 + cb), g1 = *(const LAS f32x4*)(VEC + 320 + cb);
#pragma unroll
                        for (int e = 0; e < 4; ++e) { const int cp = cb + e; const float a = acc[8 * sf + 4 * jj + e] * nqc * nk4[e];
                            v0[4 * jj + e] = (cp <= cc) ? a * __expf(fminf(Gc0 - g0[e], 0.f)) : 0.f;
                            v1[4 * jj + e] = (cp >= cc) ? a * __expf(fminf(Gc1 - g1[e], 0.f)) : 0.f; } }
                    *(bf16x8v*)(P.ws + PRE_QKF + ((size_t)u) * 8192 + (size_t)((tb * 4 + 2 * ta + sf) * 64 + lane) * 16) = pack8(v0);
                    *(bf16x8v*)(P.ws + PRE_QKF + ((size_t)NUNIT + u) * 8192 + (size_t)((tb * 4 + 2 * ta + sf) * 64 + lane) * 16) = pack8(v1); }
            }
        }
        WG_BAR_LDS();
        float x[32]; f32x16 Th;
        if (wave == 0) dn_solve_a<false>(AM, (LAS float*)(lds + P2_XT), x, Th, lane);
        else if (wave == 1) dn_solve_a<true>(AM, (LAS float*)(lds + P2_XT + 8192), x, Th, lane);
        else if (wave < 6) { if (u + G < NUNIT) P2_S1T(u + G, set ^ 1, 0, P2_TS, 0, 0); }
        else {
            if (u + G < NUNIT) P2_S1T(u + G, set ^ 1, 0, 0, 1, 1);
#pragma unroll
            for (int e = 0; e < 8; ++e) { const int idx = (wave - 6) * 8 + e; const int ct = idx >> 3, s8 = idx & 7; const bf16x8v f = pi_frag(IMG + L_QI, IST, 32 * ct, 16 * s8, lane);
                *(bf16x8v*)(P.ws + PRE_QF + (size_t)u * 16384 + (size_t)(idx * 64 + lane) * 16) = f; }
        }
        WG_BAR_LDS();
        if (wave == 0) dn_solve_b<false>(x, Th, VEC, VEC + 128, VEC + 448, IMG + L_QI, lane);
        else if (wave == 1) dn_solve_b<true>(x, Th, VEC + 64, VEC + 128 + 64, VEC + 448, lds + P2_XT, lane);
        else if (wave < 6) { if (u + G < NUNIT) P2_S1T(u + G, set ^ 1, P2_TS, 16, 0, 1); }
        WG_BAR_LDS();
        { const int kind = wave >> 2, xt = wave & 3;
            bf16x8v xf[4];
#pragma unroll
            for (int s4 = 0; s4 < 4; ++s4) xf[s4] = tr_frag(imga + (kind ? L_KI : L_VI), IST, 16 * s4, 32 * xt, lane);
            if (kind) {
#pragma unroll
                for (int s4 = 0; s4 < 4; ++s4) *(bf16x8v*)(P.ws + PRE_KTF + (size_t)u * 16384 + (size_t)((xt * 4 + s4) * 64 + lane) * 16) = xf[s4]; }
#pragma unroll 1
            for (int dc = 0; dc < 4; ++dc) { const int d = dc >> 1, ct = dc & 1;
                const LAS unsigned char* Ti = (d ? lds + P2_XT : IMG + L_QI) + kind * TIMG;
                f32x16 acc;
#pragma unroll
                for (int r = 0; r < 16; ++r) acc[r] = 0.f;
                if (kind == 0) {
#pragma unroll
                    for (int s4 = 0; s4 < 4; ++s4) acc = mfma32(pi_frag(Ti, TST, 32 * ct, 16 * s4, lane), xf[s4], acc);
                    float v[16];
#pragma unroll
                    for (int r = 0; r < 16; ++r) v[r] = acc[r];
                    bf16x8v* dst = (bf16x8v*)(outb + OUT_UF + ((size_t)d * NUNIT + u) * 16384 + (size_t)((ct * 4 + xt) * 64 + lane) * 32);
                    dst[0] = pack8(v); dst[1] = pack8(v + 8);
                } else {
#pragma unroll
                    for (int s4 = 0; s4 < 4; ++s4) acc = mfma32(xf[s4], pi_frag(Ti, TST, 32 * ct, 16 * s4, lane), acc);
                    float v[16];
#pragma unroll
                    for (int r = 0; r < 16; ++r) v[r] = -acc[r];
                    unsigned char* base = outb + OUT_WF + ((size_t)d * NUNIT + u) * 16384;
                    *(bf16x8v*)(base + (size_t)((ct * 8 + 2 * xt) * 64 + lane) * 16) = pack8(v);
                    *(bf16x8v*)(base + (size_t)((ct * 8 + 2 * xt + 1) * 64 + lane) * 16) = pack8(v + 8);
                }
            }
        }
    }
    WG_BAR_LDS();
#undef P2_REQ
#undef P2_S1
}
constexpr int SC_BUF = 58368, SC_WF = 0, SC_QF = 16384, SC_QKF = 32768, SC_KTF = 40960, SC_EG = 57344;
static_assert(2 * SC_BUF <= LDSCTL_OFF, "scan LDS map");
__device__ __forceinline__ void dn_scan2(const Ptrs& P, LAS unsigned char* lds, int wave, int lane_) {
    const unsigned char* outb = (const unsigned char*)P.out;
    for (int chain = blockIdx.x; chain < NSEQ * NH * 2; chain += gridDim.x) {
        const int d = chain & 1, h = (chain >> 1) & 7, b = chain >> 4;
        if (wave >= 4) {
            const int li = wave - 4;
#pragma unroll 1
            for (int step = -1; step < 32; ++step) {
                if (step + 1 < 32) {
                    int lane = lane_; asm volatile("" : "+v"(lane));
                    const int ci = d ? 31 - (step + 1) : (step + 1); const int u = (b * 8 + h) * 32 + ci; const size_t du = (size_t)d * NUNIT + u;
                    LAS unsigned char* buf = lds + ((step + 1) & 1) * SC_BUF;
                    const unsigned char* gWF = outb + OUT_WF + du * 16384 + lane * 16; const unsigned char* gQF = P.ws + PRE_QF + (size_t)u * 16384 + lane * 16;
                    const unsigned char* gQKF = P.ws + PRE_QKF + du * 8192 + lane * 16; const unsigned char* gKTF = P.ws + PRE_KTF + (size_t)u * 16384 + lane * 16;
#pragma unroll
                    for (int k = 0; k < 4; ++k) { const int j = li + 4 * k;
                        __builtin_amdgcn_global_load_lds((const unsigned*)(gWF + j * 1024), (LAS unsigned*)(buf + SC_WF + j * 1024), 16, 0, 0);
                        __builtin_amdgcn_global_load_lds((const unsigned*)(gQF + j * 1024), (LAS unsigned*)(buf + SC_QF + j * 1024), 16, 0, 0);
                        __builtin_amdgcn_global_load_lds((const unsigned*)(gKTF + j * 1024), (LAS unsigned*)(buf + SC_KTF + j * 1024), 16, 0, 0); }
#pragma unroll
                    for (int k = 0; k < 2; ++k) { const int j = li + 4 * k;
                        __builtin_amdgcn_global_load_lds((const unsigned*)(gQKF + j * 1024), (LAS unsigned*)(buf + SC_QKF + j * 1024), 16, 0, 0); }
                    if (li == 0) __builtin_amdgcn_global_load_lds((const unsigned*)(P.ws + WS_EG + du * 640 + lane * 16), (LAS unsigned*)(buf + SC_EG), 16, 0, 0);
                    asm volatile("s_waitcnt vmcnt(0)" ::: "memory");
                }
                WG_BAR_LDS();
            }
        } else {
            const int dvb = wave;
            f32x16 S[4];
#pragma unroll
            for (int k = 0; k < 4; ++k)
#pragma unroll
                for (int r = 0; r < 16; ++r) S[k][r] = 0.f;
            bf16* Od = (bf16*)(P.ws + WS_O) + (size_t)d * M * 1024;
            v4u un[4];
            { const int ci0 = d ? 31 : 0; const size_t du0 = (size_t)d * NUNIT + (b * 8 + h) * 32 + ci0; const v4u* UF = (const v4u*)(outb + OUT_UF + du0 * 16384);
#pragma unroll
              for (int ct = 0; ct < 2; ++ct) { un[2 * ct] = UF[((ct * 4 + dvb) * 64 + lane_) * 2]; un[2 * ct + 1] = UF[((ct * 4 + dvb) * 64 + lane_) * 2 + 1]; } }
            WG_BAR_LDS();
#pragma unroll 1
            for (int step = 0; step < 32; ++step) {
                int lane = lane_; asm volatile("" : "+v"(lane));
                const int hh = lane >> 5, r31 = lane & 31;
                const int ci = d ? 31 - step : step;
                const LAS unsigned char* buf = lds + (step & 1) * SC_BUF + lane * 16;
                const LAS float* rec = (const LAS float*)(lds + (step & 1) * SC_BUF + SC_EG);
                f32x16 va[2], oa[2];
#pragma unroll
                for (int ct = 0; ct < 2; ++ct) { const v4u u0 = un[2 * ct], u1 = un[2 * ct + 1];
                    va[ct][0] = bf_lo(u0.x); va[ct][1] = bf_hi(u0.x); va[ct][2] = bf_lo(u0.y); va[ct][3] = bf_hi(u0.y); va[ct][4] = bf_lo(u0.z); va[ct][5] = bf_hi(u0.z); va[ct][6] = bf_lo(u0.w); va[ct][7] = bf_hi(u0.w);
                    va[ct][8] = bf_lo(u1.x); va[ct][9] = bf_hi(u1.x); va[ct][10] = bf_lo(u1.y); va[ct][11] = bf_hi(u1.y); va[ct][12] = bf_lo(u1.z); va[ct][13] = bf_hi(u1.z); va[ct][14] = bf_lo(u1.w); va[ct][15] = bf_hi(u1.w);
#pragma unroll
                    for (int r = 0; r < 16; ++r) oa[ct][r] = 0.f; }
                if (step + 1 < 32) { const int cn = d ? 31 - (step + 1) : (step + 1); const size_t dun = (size_t)d * NUNIT + (b * 8 + h) * 32 + cn; const v4u* UF = (const v4u*)(outb + OUT_UF + dun * 16384);
#pragma unroll
                    for (int ct = 0; ct < 2; ++ct) { un[2 * ct] = UF[((ct * 4 + dvb) * 64 + lane) * 2]; un[2 * ct + 1] = UF[((ct * 4 + dvb) * 64 + lane) * 2 + 1]; } }
#pragma unroll
                for (int s8 = 0; s8 < 8; ++s8) { float sv[8];
#pragma unroll
                    for (int j = 0; j < 8; ++j) sv[j] = S[s8 >> 1][8 * (s8 & 1) + j];
                    const bf16x8v Sb = pack8(sv);
#pragma unroll
                    for (int ct = 0; ct < 2; ++ct) { va[ct] = mfma32(*(const LAS bf16x8v*)(buf + SC_WF + (ct * 8 + s8) * 1024), Sb, va[ct]); oa[ct] = mfma32(*(const LAS bf16x8v*)(buf + SC_QF + (ct * 8 + s8) * 1024), Sb, oa[ct]); } }
                bf16x8v vb[4], vs[4];
#pragma unroll
                for (int ct = 0; ct < 2; ++ct) {
#pragma unroll
                    for (int q4 = 0; q4 < 4; ++q4) { const f32x4 eg = *(const LAS f32x4*)(rec + 32 * ct + 8 * q4 + 4 * hh), el = *(const LAS f32x4*)(rec + 64 + 32 * ct + 8 * q4 + 4 * hh);
#pragma unroll
                        for (int e = 0; e < 4; ++e) oa[ct][4 * q4 + e] *= eg[e];
                        if (q4 & 1) { float p[8], sc[8];
#pragma unroll
                            for (int e = 0; e < 4; ++e) { p[4 + e] = va[ct][4 * q4 + e]; sc[4 + e] = p[4 + e] * el[e]; }
                            const f32x4 el0 = *(const LAS f32x4*)(rec + 64 + 32 * ct + 8 * (q4 - 1) + 4 * hh);
#pragma unroll
                            for (int e = 0; e < 4; ++e) { p[e] = va[ct][4 * (q4 - 1) + e]; sc[e] = p[e] * el0[e]; }
                            vb[2 * ct + (q4 >> 1)] = pack8(p); vs[2 * ct + (q4 >> 1)] = pack8(sc); } } }
#pragma unroll
                for (int s4 = 0; s4 < 4; ++s4)
#pragma unroll
                    for (int ct = 0; ct < 2; ++ct) oa[ct] = mfma32(*(const LAS bf16x8v*)(buf + SC_QKF + (ct * 4 + s4) * 1024), vb[s4], oa[ct]);
                const float egl = rec[128];
#pragma unroll
                for (int dkt = 0; dkt < 4; ++dkt) {
#pragma unroll
                    for (int r = 0; r < 16; ++r) S[dkt][r] *= egl;
#pragma unroll
                    for (int s4 = 0; s4 < 4; ++s4) S[dkt] = mfma32(*(const LAS bf16x8v*)(buf + SC_KTF + (dkt * 4 + s4) * 1024), vs[s4], S[dkt]); }
                bf16* op = Od + ((size_t)b * SEQ + ci * 64) * 1024 + h * HD + 32 * dvb + (r31 & ~1);
#pragma unroll
                for (int ct = 0; ct < 2; ++ct)
#pragma unroll
                    for (int r = 0; r < 16; r += 2) { const float a = oa[ct][r], bq = oa[ct][r + 1];
                        const float na = dpp_get<0xB1, 0xF>(a), nb = dpp_get<0xB1, 0xF>(bq);
                        const bool odd = r31 & 1; const unsigned w = odd ? pk2(nb, bq) : pk2(a, na);
                        *(unsigned*)(op + (size_t)(32 * ct + rowof(r + (odd ? 1 : 0), hh)) * 1024) = w; }
                WG_BAR_LDS();
            }
        }
        WG_BAR_LDS();
    }
}
__device__ __forceinline__ float row16_sum(float v) {
    v += dpp_get<0xB1, 0xF>(v); v += dpp_get<0x4E, 0xF>(v); v += dpp_get<0x141, 0xF>(v); v += dpp_get<0x140, 0xF>(v); return v; }
__device__ __forceinline__ void dn_combine(const Ptrs& P, int gw, int NGW, int lane) {
    const bf16* O = (const bf16*)(P.ws + WS_O); const bf16* Z = (const bf16*)(P.ws + WS_Z); bf16* Y = (bf16*)(P.ws + WS_XN);
    const int cl = 8 * (lane & 15);
    const f32x4 nw0 = *(const f32x4*)(P.dn_norm_w + cl), nw1 = *(const f32x4*)(P.dn_norm_w + cl + 4);
    const float nw[8] = {nw0[0], nw0[1], nw0[2], nw0[3], nw1[0], nw1[1], nw1[2], nw1[3]};
    for (int it0 = gw * 2; it0 < M * 2; it0 += NGW * 2) {
        v4u a[2], bq[2], zz[2]; size_t off[2];
#pragma unroll
        for (int k = 0; k < 2; ++k) { const int it = it0 + k, m = it >> 1, hq = it & 1; off[k] = (size_t)m * 1024 + (hq * 4 + (lane >> 4)) * HD + cl;
            a[k] = *(const v4u*)(O + off[k]); bq[k] = *(const v4u*)(O + (size_t)M * 1024 + off[k]); zz[k] = *(const v4u*)(Z + off[k]); }
#pragma unroll
        for (int k = 0; k < 2; ++k) { const int it = it0 + k, m = it >> 1;
            const unsigned aw[4] = {a[k].x, a[k].y, a[k].z, a[k].w}, bw[4] = {bq[k].x, bq[k].y, bq[k].z, bq[k].w}, zw[4] = {zz[k].x, zz[k].y, zz[k].z, zz[k].w};
            float o[8], z[8]; float ss = 0.f;
#pragma unroll
            for (int e = 0; e < 4; ++e) { o[2 * e] = bf_lo(aw[e]) + bf_lo(bw[e]); o[2 * e + 1] = bf_hi(aw[e]) + bf_hi(bw[e]); z[2 * e] = bf_lo(zw[e]); z[2 * e + 1] = bf_hi(zw[e]); ss += o[2 * e] * o[2 * e] + o[2 * e + 1] * o[2 * e + 1]; }
            const float rn = rsqrtf(row16_sum(ss) * (1.0f / HD) + RMS_EPS);
            float y[8];
#pragma unroll
            for (int e = 0; e < 8; ++e) y[e] = o[e] * rn * nw[e] * (z[e] * __builtin_amdgcn_rcpf(1.0f + __expf(-z[e])));
            v4u w; w.x = pk2(y[0], y[1]); w.y = pk2(y[2], y[3]); w.z = pk2(y[4], y[5]); w.w = pk2(y[6], y[7]);
            *(v4u*)(Y + (size_t)m * DM + 1024 + (off[k] - (size_t)m * 1024)) = w; }
    }
}

struct Args { const float* in[15]; float* out; unsigned char* ws; int pad0, pad1; };
typedef const __attribute__((address_space(4))) Args* KArgs;
__device__ __forceinline__ int lane_id_opaque() { int l; asm volatile("v_mbcnt_lo_u32_b32 %0, -1, 0\n\tv_mbcnt_hi_u32_b32 %0, -1, %0" : "=v"(l)); return l; }
__device__ __forceinline__ void load_ptrs(Ptrs& P, KArgs a) {
    asm volatile("" : "+s"(a));
    P.xp = a->in[0]; P.xs = a->in[1]; P.norm_mix_w = a->in[2]; P.w_in = a->in[3]; P.rpb = a->in[4]; P.conv_w = a->in[5]; P.A_log = a->in[6]; P.dt_bias = a->in[7];
    P.dn_norm_w = a->in[8]; P.w_out = a->in[9]; P.norm_ffn_w = a->in[10]; P.w_gate = a->in[11]; P.w_up = a->in[12]; P.w_down = a->in[13]; P.final_norm_w = a->in[14];
    P.out = a->out; P.ws = a->ws;
}
__global__ void __launch_bounds__(512, 2) fwd(Args args) {
    extern __shared__ __attribute__((aligned(16))) unsigned char lds_raw[];
    LAS unsigned char* lds = (LAS unsigned char*)lds_raw;
    const int wave = __builtin_amdgcn_readfirstlane(threadIdx.x >> 6);
    const KArgs ka = (KArgs)__builtin_amdgcn_kernarg_segment_ptr();
    const int G = gridDim.x, NGW = G * 8, gw = blockIdx.x * 8 + wave;
    XcdBarrier bar;
    { const int lane = lane_id_opaque(); const int tid = wave * 64 + lane;
      for (int u = tid; u < (LDS_BYTES - LDSCTL_OFF) / 4; u += 512) ((LAS unsigned*)(lds + LDSCTL_OFF))[u] = 0u;
      __syncthreads();
      bar = xcd_barrier_post(g_xbar, (volatile LAS unsigned*)(lds + MISC_OFF) + 8, tid == 0); }
#define SEAM() do { const int l_ = lane_id_opaque(); xcd_barrier(bar, wave == 0 && l_ == 0); } while (0)
#define PHASE_BEGIN() const int lane = lane_id_opaque(); const int tid = wave * 64 + lane; (void)tid; Ptrs P; load_ptrs(P, ka)

    { PHASE_BEGIN(); p0_prologue(P, lds, gw, NGW, wave, lane);
      for (int i = (int)blockIdx.x * 512 + tid; i < M; i += G * 512) ((unsigned long long*)(P.ws + WS_SSQ))[i] = 0ull; } SEAM();
    { PHASE_BEGIN();
        pg8::Gemm g{(const bf16*)(P.ws + WS_XN), (const bf16*)(P.ws + WS_W1), M, NPROJ, DM}; pg8::StaticOrder S; S.init(M, NPROJ, G, (int)blockIdx.x);
        pg8::EpiProj E{(bf16*)(P.ws + WS_PROJ), PROJ_STRIDE / 2, (bf16*)(P.ws + WS_Z), (float*)(P.ws + WS_BA)};
        pg8::gemm_phase<pg8::EpiProj, pg8::StaticOrder, PG8_ALIGN, PG8_SP2>(lds + RING_OFF, g, S, E, wave, lane);
        { const int rem = S.nwg % G; if (rem && (int)blockIdx.x >= rem) wconv_items(P, lds, IT_WO, IT_G, ((int)blockIdx.x - rem) * 8 + wave, (G - rem) * 8, wave, lane); }
    } SEAM();
    { PHASE_BEGIN(); na_mfma(P, lds, wave, lane); asm volatile("s_waitcnt vmcnt(0)" ::: "memory"); __syncthreads(); }
    { PHASE_BEGIN(); dn_pre2(P, lds, tid, wave, lane); } SEAM();
    { PHASE_BEGIN();
        if ((int)blockIdx.x >= NSEQ * NH * 2) wconv_items(P, lds, IT_G, IT_D, ((int)blockIdx.x - NSEQ * NH * 2) * 8 + wave, (G - NSEQ * NH * 2) * 8, wave, lane);
        else dn_scan2(P, lds, wave, lane);
    } SEAM();
    { PHASE_BEGIN(); dn_combine(P, gw, NGW, lane); } SEAM();
    { PHASE_BEGIN();
        pg8::Gemm g{(const bf16*)(P.ws + WS_XN), (const bf16*)(P.ws + WS_WO), M, DM, DM}; pg8::StaticOrder S; S.init(M, DM, G, (int)blockIdx.x);
        pg8::EpiResid E{P.xp, P.xs, (bf16*)(P.ws + WS_H16), (unsigned long long*)(P.ws + WS_SSQ)};
        pg8::gemm_phase<pg8::EpiResid, pg8::StaticOrder, PG8_ALIGN, PG8_SP2>(lds + RING_OFF, g, S, E, wave, lane);
    } SEAM();
    { PHASE_BEGIN();
        pg8::Gemm g{(const bf16*)(P.ws + WS_H16), (const bf16*)(P.ws + WS_W3), M, NGU, DM}; pg8::StaticOrder S; S.init(M, NGU, G, (int)blockIdx.x);
        pg8::Unit u0; u0.pm = 0; u0.pn = 0; (void)S.next(0, u0);
        LAS float* rsl = (LAS float*)(lds + RSTD_OFF);
        { const int sl = tid >> 7, pm = 8 * ((u0.pm >> 3) + sl) + (u0.pm & 7); unsigned long long* q = (unsigned long long*)(P.ws + WS_SSQ) + (size_t)pm * 256 + (tid & 127);
#pragma unroll
          for (int e = 0; e < 2; ++e) { float r = 0.f;
              if (pm < M / 256) r = rsqrtf((float)__hip_atomic_load(q + 128 * e, __ATOMIC_RELAXED, __HIP_MEMORY_SCOPE_AGENT) * (1.f / (SSQ_SCALE * DM)) + RMS_EPS);
              rsl[sl * 256 + (tid & 127) + 128 * e] = r; } }
        __syncthreads();
        pg8::EpiSwiGLU E{(bf16*)(P.ws + WS_ACT), rsl, u0.pm >> 3};
        pg8::gemm_phase<pg8::EpiSwiGLU, pg8::StaticOrder, PG8_ALIGN, PG8_SP2>(lds + RING_OFF, g, S, E, wave, lane);
        { const int rem = S.nwg % G; if (rem && (int)blockIdx.x >= rem) wconv_items(P, lds, IT_D, IT_END, ((int)blockIdx.x - rem) * 8 + wave, (G - rem) * 8, wave, lane); }
    } SEAM();
    { PHASE_BEGIN();
        pg8::Gemm g{(const bf16*)(P.ws + WS_ACT), (const bf16*)(P.ws + WS_W4), M, DM, DFF}; pg8::StaticOrder S; S.init(M, DM, G, (int)blockIdx.x);
        pg8::EpiDown E{(bf16*)(P.ws + WS_F16)};
        pg8::gemm_phase<pg8::EpiDown, pg8::StaticOrder, PG8_ALIGN, PG8_SP2>(lds + RING_OFF, g, S, E, wave, lane);
    } SEAM();
    { PHASE_BEGIN(); if (wave == 0) xcd_barrier_retire(bar, lane);
      for (int m = gw; m < M; m += NGW) rms_row_sum2_to_f32((const bf16*)(P.ws + WS_H16) + (size_t)m * DM, (const bf16*)(P.ws + WS_F16) + (size_t)m * DM, P.final_norm_w, P.out + (size_t)m * DM, lane); }
#undef SEAM
#undef PHASE_BEGIN
}

extern "C" void kernel_launch(void* const* d_in, const int* in_sizes, int n_in, void* d_out, int out_size, void* d_ws, size_t ws_size, hipStream_t stream) {
    static int grid = 0;
    if (grid == 0) {
        if (n_in != 15 || out_size != M * DM || ws_size < WS_END) { fprintf(stderr, "kernel_launch: unexpected shapes (n_in %d out %d ws %zu)\n", n_in, out_size, ws_size); grid = -1; return; }
        int dev = 0, cus = 0, per_cu = 0;
        if (hipGetDevice(&dev) != hipSuccess || hipDeviceGetAttribute(&cus, hipDeviceAttributeMultiprocessorCount, dev) != hipSuccess) { grid = -1; return; }
        if (cus != 256) { fprintf(stderr, "kernel_launch: built for 256 CUs (one resident 512-thread workgroup each), found %d\n", cus); grid = -1; return; }
        if (hipFuncSetAttribute((const void*)fwd, hipFuncAttributeMaxDynamicSharedMemorySize, LDS_BYTES) != hipSuccess) { grid = -1; return; }
        if (hipOccupancyMaxActiveBlocksPerMultiprocessor(&per_cu, (const void*)fwd, 512, LDS_BYTES) != hipSuccess || per_cu < 1) fprintf(stderr, "kernel_launch: occupancy query says %d\n", per_cu);
        (void)hipGetLastError();
        grid = cus;
    }
    if (grid < 0) return;
    Args a{};
    for (int i = 0; i < 15; ++i) a.in[i] = (const float*)d_in[i];
    a.out = (float*)d_out; a.ws = (unsigned char*)d_ws;
    hipLaunchKernelGGL(fwd, dim3(grid), dim3(512), LDS_BYTES, stream, a);
}
```
